# Optimizing an MI355X kernel written in HIP

```python
import math
import jax
import jax.numpy as jnp
from jax import lax
import numpy as np

D_MODEL = 1024
BATCH = 8
SEQ = 2048
DEPTH = 2

MEM_LEN = 256
HEAD_DIM = 128
A_HEADS = 8
B_HEADS = 8
A_WIDTH = A_HEADS * HEAD_DIM
B_WIDTH = B_HEADS * HEAD_DIM
EVEN_WIDTH = A_WIDTH + B_WIDTH
EVEN_IN = 3 * A_WIDTH + 3 * B_WIDTH + EVEN_WIDTH
C_WIDTH = D_MODEL
C_BLOCKS = 8
C_BLOCK_DIM = C_WIDTH // C_BLOCKS
CONV_WIDTH = 4
RG_C = 8.0
D_HEADS = 8
D_WIDTH = D_HEADS * HEAD_DIM
ODD_WIDTH = C_WIDTH + D_WIDTH
ODD_IN = C_WIDTH + 3 * D_WIDTH + ODD_WIDTH
HGRN_CHUNK = 32
RET_CHUNK = 64
MOBA_BLOCK = 256
MOBA_TOPK = 3
MOBA_QCHUNK = 16
ROPE_THETA = 500000.0
ROPE_DIM = HEAD_DIM // 4
RET_THETA = 10000.0
XA_HEADS = 4
XA_HEAD_DIM = 128
XA_WIDTH = XA_HEADS * XA_HEAD_DIM
N_EVEN = (DEPTH + 1) // 2
N_ODD = DEPTH // 2
EPS = 1e-6

kernel_name = 'hybrid_hgrn2_moba_rglru_retention'


def rms_norm(x, gain):
    xf = x.astype(jnp.float32)
    y = xf * lax.rsqrt(jnp.mean(xf * xf, axis=-1, keepdims=True) + EPS)
    return (y * gain.astype(jnp.float32)).astype(x.dtype)


def head_rms_norm(o, gain):
    H, d = o.shape[-2:]
    y = o * lax.rsqrt(jnp.mean(o * o, axis=-1, keepdims=True) + EPS)
    return y * gain.astype(jnp.float32).reshape(H, d)


def head_group_norm(o, gain, bias):
    H, d = o.shape[-2:]
    mu = jnp.mean(o, axis=-1, keepdims=True)
    var = jnp.mean(jnp.square(o - mu), axis=-1, keepdims=True)
    y = (o - mu) * lax.rsqrt(var + EPS)
    return y * gain.astype(jnp.float32).reshape(H, d) + bias.astype(jnp.float32).reshape(H, d)


def rotary(x, pos, rot_dim, theta):
    half = rot_dim // 2
    inv = theta ** (-jnp.arange(half, dtype=jnp.float32) / half)
    ang = pos.astype(jnp.float32)[..., None] * inv
    cos = jnp.cos(ang)[:, :, None, :]
    sin = jnp.sin(ang)[:, :, None, :]
    xf = x.astype(jnp.float32)
    x1, x2, rest = xf[..., :half], xf[..., half:rot_dim], xf[..., rot_dim:]
    out = jnp.concatenate([x1 * cos - x2 * sin, x2 * cos + x1 * sin, rest], axis=-1)
    return out.astype(x.dtype)


def chunk_state_scan(decay, u):
    def step(s, inp):
        dec, uc = inp
        return dec * s + uc, s
    s0 = jnp.zeros(u.shape[:2] + u.shape[3:], u.dtype)
    _, s_prev = lax.scan(step, s0, (jnp.moveaxis(decay, 2, 0), jnp.moveaxis(u, 2, 0)))
    return jnp.moveaxis(s_prev, 0, 2)


def hgrn2_chunked(q, f_logit, i, lb):
    B, S, H, d = q.shape
    n = S // HGRN_CHUNK
    def to_chunks(t):
        return t.astype(jnp.float32).reshape(B, n, HGRN_CHUNK, H, d).transpose(0, 3, 1, 2, 4)
    lbb = lb.astype(jnp.float32)[None, :, None, None, :]
    f = lbb + (1.0 - lbb) * jax.nn.sigmoid(to_chunks(f_logit))
    k = 1.0 - f
    qc, vc = to_chunks(q), to_chunks(i)
    b = jnp.cumsum(jnp.log(f), axis=3)
    b_last = b[:, :, :, -1:, :]
    q_dec = qc * jnp.exp(b)
    k_inv = k * jnp.exp(-b)
    k_end = k * jnp.exp(b_last - b)
    causal = jnp.tril(jnp.ones((HGRN_CHUNK, HGRN_CHUNK), bool))
    att = jnp.where(causal, jnp.einsum('bhncd,bhnsd->bhncs', q_dec, k_inv), 0.0)
    o_intra = jnp.einsum('bhncs,bhnsv->bhncv', att, vc)
    u = jnp.einsum('bhnsd,bhnsv->bhndv', k_end, vc)
    decay = jnp.exp(b_last[:, :, :, 0, :])[..., None]
    s_prev = chunk_state_scan(decay, u)
    o_inter = jnp.einsum('bhncd,bhndv->bhncv', q_dec, s_prev)
    return (o_intra + o_inter).transpose(0, 2, 3, 1, 4).reshape(B, S, H, d)


def moba_attention(q, k, v):
    B, S, H, d = q.shape
    nb = -(-S // MOBA_BLOCK)
    s_pad = nb * MOBA_BLOCK
    n_sel = min(MOBA_TOPK, nb - 1)
    n_chunks = s_pad // MOBA_QCHUNK
    scale = d ** -0.5
    def to_bhsd(t):
        t = t.astype(jnp.float32).transpose(0, 2, 1, 3)
        return jnp.pad(t, ((0, 0), (0, 0), (0, s_pad - S), (0, 0)))
    q, k, v = to_bhsd(q), to_bhsd(k), to_bhsd(v)
    k_blocks = k.reshape(B, H, nb, MOBA_BLOCK, d)
    v_blocks = v.reshape(B, H, nb, MOBA_BLOCK, d)
    if n_sel > 0:
        k_mean = jnp.mean(k_blocks, axis=3)
        gate = jnp.einsum('bhsd,bhnd->bhsn', q, k_mean)
        q_block = jnp.arange(s_pad) // MOBA_BLOCK
        fully_past = jnp.arange(nb)[None, :] < q_block[:, None]
        gate = jnp.where(fully_past, gate, -jnp.inf)
        top_val, top_idx = lax.top_k(gate, n_sel)
        sel_valid = jnp.isfinite(top_val)
    else:
        top_idx = jnp.zeros((B, H, s_pad, 0), jnp.int32)
        sel_valid = jnp.zeros((B, H, s_pad, 0), bool)
    def per_chunk(t):
        return jnp.moveaxis(t.reshape(B, H, n_chunks, MOBA_QCHUNK, *t.shape[3:]), 2, 0)
    b_ix = jnp.arange(B)[:, None, None, None]
    h_ix = jnp.arange(H)[None, :, None, None]
    n_gather = n_sel * MOBA_BLOCK
    def attend(args):
        c, qc, idx, valid = args
        start = c * MOBA_QCHUNK
        own = start // MOBA_BLOCK
        k_own = lax.dynamic_slice_in_dim(k, own * MOBA_BLOCK, MOBA_BLOCK, axis=2)
        v_own = lax.dynamic_slice_in_dim(v, own * MOBA_BLOCK, MOBA_BLOCK, axis=2)
        q_pos = start + jnp.arange(MOBA_QCHUNK)
        k_pos = own * MOBA_BLOCK + jnp.arange(MOBA_BLOCK)
        s_own = jnp.einsum('bhqd,bhjd->bhqj', qc, k_own) * scale
        s_own = jnp.where(k_pos[None, :] <= q_pos[:, None], s_own, -jnp.inf)
        k_sel = k_blocks[b_ix, h_ix, idx]
        v_sel = v_blocks[b_ix, h_ix, idx]
        s_sel = jnp.einsum('bhqd,bhqnjd->bhqnj', qc, k_sel) * scale
        s_sel = jnp.where(valid[..., None], s_sel, -jnp.inf)
        p = jax.nn.softmax(jnp.concatenate([s_sel.reshape(B, H, MOBA_QCHUNK, n_gather), s_own], axis=-1), axis=-1)
        p_sel = p[..., :n_gather].reshape(B, H, MOBA_QCHUNK, n_sel, MOBA_BLOCK)
        p_own = p[..., n_gather:]
        return jnp.einsum('bhqnj,bhqnjd->bhqd', p_sel, v_sel) + jnp.einsum('bhqj,bhjd->bhqd', p_own, v_own)
    out = lax.map(attend, (jnp.arange(n_chunks), per_chunk(q), per_chunk(top_idx), per_chunk(sel_valid)))
    out = jnp.moveaxis(out, 0, 2).reshape(B, H, s_pad, d)[:, :, :S]
    return out.transpose(0, 2, 1, 3)


def rglru_branch(cx, conv_w, conv_b, wa, ba, wx, bx, lam):
    B, S, C = cx.shape
    xc = lax.conv_general_dilated(cx, conv_w[:, None, :], window_strides=(1,),
                                  padding=[(CONV_WIDTH - 1, 0)],
                                  dimension_numbers=('NWC', 'WIO', 'NWC'),
                                  feature_group_count=C)
    xf = xc.astype(jnp.float32) + conv_b.astype(jnp.float32)
    xb = xf.reshape(B, S, C_BLOCKS, C_BLOCK_DIM)
    r = jax.nn.sigmoid(jnp.einsum('bshi,hij->bshj', xb, wa.astype(jnp.float32)).reshape(B, S, C) + ba.astype(jnp.float32))
    ig = jax.nn.sigmoid(jnp.einsum('bshi,hij->bshj', xb, wx.astype(jnp.float32)).reshape(B, S, C) + bx.astype(jnp.float32))
    log_a = -RG_C * r * jax.nn.softplus(-lam.astype(jnp.float32))
    a = jnp.exp(log_a)
    u = jnp.sqrt(-jnp.expm1(2.0 * log_a)) * ig * xf
    def combine(left, right):
        a1, b1 = left
        a2, b2 = right
        return a1 * a2, a2 * b1 + b2
    _, h = lax.associative_scan(combine, (a, u), axis=1)
    return h


def retention_chunked(q, k, v, pos):
    B, S, H, d = q.shape
    n = S // RET_CHUNK
    q = rotary(q, pos, d, RET_THETA)
    k = rotary(k, pos, d, RET_THETA)
    def to_chunks(t):
        return t.astype(jnp.float32).reshape(B, n, RET_CHUNK, H, d).transpose(0, 3, 1, 2, 4)
    qc, kc, vc = to_chunks(q), to_chunks(k) * (d ** -0.5), to_chunks(v)
    log_g = jnp.log(1.0 - 2.0 ** (-5.0 - jnp.arange(H, dtype=jnp.float32)))
    idx = jnp.arange(RET_CHUNK, dtype=jnp.float32)
    diff = idx[:, None] - idx[None, :]
    dmask = jnp.where(diff >= 0, jnp.exp(jnp.maximum(diff, 0.0) * log_g[:, None, None]), 0.0)
    att = jnp.einsum('bhncd,bhnsd->bhncs', qc, kc) * dmask[None, :, None]
    o_intra = jnp.einsum('bhncs,bhnsv->bhncv', att, vc)
    q_dec = qc * jnp.exp((idx + 1.0)[None, :] * log_g[:, None])[None, :, None, :, None]
    k_end = kc * jnp.exp((RET_CHUNK - 1.0 - idx)[None, :] * log_g[:, None])[None, :, None, :, None]
    u = jnp.einsum('bhnsd,bhnsv->bhndv', k_end, vc)
    chunk_decay = jnp.broadcast_to(jnp.exp(RET_CHUNK * log_g)[None, :, None, None, None], (1, H, n, 1, 1))
    s_prev = chunk_state_scan(chunk_decay, u)
    o_inter = jnp.einsum('bhncd,bhndv->bhncv', q_dec, s_prev)
    return (o_intra + o_inter).transpose(0, 2, 3, 1, 4).reshape(B, S, H, d)


def even_mixer(xn, pos, lb, w_in, hgrn_gain, w_out):
    B, S, _ = xn.shape
    h = jnp.einsum('bsd,de->bse', xn, w_in)
    splits = np.cumsum([A_WIDTH] * 3 + [B_WIDTH] * 3).tolist()
    aq, af, ai, bq, bk, bv, z = jnp.split(h, splits, axis=-1)
    def heads(t):
        return t.reshape(B, S, -1, HEAD_DIM)
    oa = hgrn2_chunked(heads(aq), heads(af), heads(ai), lb.reshape(A_HEADS, HEAD_DIM))
    oa = head_rms_norm(oa, hgrn_gain)
    ob = moba_attention(rotary(heads(bq), pos, ROPE_DIM, ROPE_THETA),
                        rotary(heads(bk), pos, ROPE_DIM, ROPE_THETA), heads(bv))
    y = jnp.concatenate([oa.reshape(B, S, A_WIDTH), ob.reshape(B, S, B_WIDTH)], axis=-1).astype(xn.dtype)
    y = y * jax.nn.silu(z)
    return jnp.einsum('bse,ed->bsd', y, w_out)


def odd_mixer(xn, pos, w_in, conv_w, conv_b, wa, ba, wx, bx, lam, ret_gain, ret_bias, w_out):
    B, S, _ = xn.shape
    h = jnp.einsum('bsd,de->bse', xn, w_in)
    splits = np.cumsum([C_WIDTH] + [D_WIDTH] * 3).tolist()
    cx, dq, dk, dv, z = jnp.split(h, splits, axis=-1)
    oc = rglru_branch(cx, conv_w, conv_b, wa, ba, wx, bx, lam)
    def heads(t):
        return t.reshape(B, S, D_HEADS, HEAD_DIM)
    od = head_group_norm(retention_chunked(heads(dq), heads(dk), heads(dv), pos), ret_gain, ret_bias)
    y = jnp.concatenate([oc, od.reshape(B, S, D_WIDTH)], axis=-1).astype(xn.dtype)
    y = y * jax.nn.silu(z)
    return jnp.einsum('bse,ed->bsd', y, w_out)


def memory_cross_attention(xn, mem, mem_gain, wq, wkv, wo):
    B, S, _ = xn.shape
    M = mem.shape[1]
    mn = rms_norm(mem, mem_gain)
    q = jnp.einsum('bsd,de->bse', xn, wq).reshape(B, S, XA_HEADS, XA_HEAD_DIM)
    kv = jnp.einsum('bmd,de->bme', mn, wkv)
    k, v = jnp.split(kv, 2, axis=-1)
    k = k.reshape(B, M, XA_HEADS, XA_HEAD_DIM)
    v = v.reshape(B, M, XA_HEADS, XA_HEAD_DIM)
    s = jnp.einsum('bqhd,bkhd->bhqk', q.astype(jnp.float32), k.astype(jnp.float32)) * (XA_HEAD_DIM ** -0.5)
    p = jax.nn.softmax(s, axis=-1)
    o = jnp.einsum('bhqk,bkhd->bqhd', p, v.astype(jnp.float32)).reshape(B, S, XA_WIDTH).astype(xn.dtype)
    return jnp.einsum('bse,ed->bsd', o, wo)


def setup_inputs(seed: int = 0) -> dict:
    key = jax.random.key(seed)
    ks = jax.random.split(key, 26)
    def w(k, shape, fan_in, scale=1.0):
        return jax.random.normal(k, shape, jnp.float32) * (scale * fan_in ** -0.5)
    def gain(k, shape):
        return 1.0 + 0.02 * jax.random.normal(k, shape, jnp.float32)
    def small(k, shape):
        return 0.02 * jax.random.normal(k, shape, jnp.float32)
    x = jax.random.normal(ks[0], (BATCH, SEQ, D_MODEL), jnp.float32)
    mem = jax.random.normal(ks[1], (BATCH, MEM_LEN, D_MODEL), jnp.float32)
    offsets = jax.random.randint(ks[2], (BATCH, 1), 0, 4096, dtype=jnp.int32)
    positions = (jnp.arange(SEQ, dtype=jnp.int32)[None, :] + offsets).astype(jnp.int32)
    u = jax.random.uniform(ks[16], (N_ODD, C_WIDTH), jnp.float32, minval=0.9, maxval=0.999)
    a0 = u ** (1.0 / RG_C)
    lam = jnp.log(a0) - jnp.log1p(-a0)
    return {
        'x': x,
        'mem': mem,
        'positions': positions,
        'hgrn_lb_logits': 0.5 * jax.random.normal(ks[3], (DEPTH + 1, A_WIDTH), jnp.float32),
        'ev_norm': gain(ks[4], (N_EVEN, D_MODEL)),
        'ev_w_in': w(ks[5], (N_EVEN, D_MODEL, EVEN_IN), D_MODEL),
        'ev_hgrn_gain': gain(ks[6], (N_EVEN, A_WIDTH)),
        'ev_w_out': w(ks[7], (N_EVEN, EVEN_WIDTH, D_MODEL), EVEN_WIDTH),
        'od_norm': gain(ks[8], (N_ODD, D_MODEL)),
        'od_w_in': w(ks[9], (N_ODD, D_MODEL, ODD_IN), D_MODEL),
        'od_conv_w': w(ks[10], (N_ODD, CONV_WIDTH, C_WIDTH), CONV_WIDTH),
        'od_conv_b': small(ks[11], (N_ODD, C_WIDTH)),
        'od_rg_wa': w(ks[12], (N_ODD, C_BLOCKS, C_BLOCK_DIM, C_BLOCK_DIM), C_BLOCK_DIM),
        'od_rg_ba': small(ks[13], (N_ODD, C_WIDTH)),
        'od_rg_wx': w(ks[14], (N_ODD, C_BLOCKS, C_BLOCK_DIM, C_BLOCK_DIM), C_BLOCK_DIM),
        'od_rg_bx': small(ks[15], (N_ODD, C_WIDTH)),
        'od_rg_lambda': lam,
        'od_ret_gain': gain(ks[17], (N_ODD, D_WIDTH)),
        'od_ret_bias': small(ks[18], (N_ODD, D_WIDTH)),
        'od_w_out': w(ks[19], (N_ODD, ODD_WIDTH, D_MODEL), ODD_WIDTH),
        'xa_norm': gain(ks[20], (DEPTH, D_MODEL)),
        'xa_mem_norm': gain(ks[21], (DEPTH, D_MODEL)),
        'xa_wq': w(ks[22], (DEPTH, D_MODEL, XA_WIDTH), D_MODEL),
        'xa_wkv': w(ks[23], (DEPTH, D_MODEL, 2 * XA_WIDTH), D_MODEL),
        'xa_wo': w(ks[24], (DEPTH, XA_WIDTH, D_MODEL), XA_WIDTH),
        'final_norm': gain(ks[25], (D_MODEL,)),
    }


def reference(x, mem, positions, hgrn_lb_logits, ev_norm, ev_w_in, ev_hgrn_gain, ev_w_out,
              od_norm, od_w_in, od_conv_w, od_conv_b, od_rg_wa, od_rg_ba, od_rg_wx, od_rg_bx,
              od_rg_lambda, od_ret_gain, od_ret_bias, od_w_out,
              xa_norm, xa_mem_norm, xa_wq, xa_wkv, xa_wo, final_norm):
    lb_all = jnp.cumsum(jax.nn.softmax(hgrn_lb_logits.astype(jnp.float32), axis=0), axis=0)
    for layer in range(DEPTH):
        if layer % 2 == 0:
            e = layer // 2
            x = x + even_mixer(rms_norm(x, ev_norm[e]), positions, lb_all[layer],
                               ev_w_in[e], ev_hgrn_gain[e], ev_w_out[e])
        else:
            o = layer // 2
            x = x + odd_mixer(rms_norm(x, od_norm[o]), positions, od_w_in[o], od_conv_w[o], od_conv_b[o],
                              od_rg_wa[o], od_rg_ba[o], od_rg_wx[o], od_rg_bx[o], od_rg_lambda[o],
                              od_ret_gain[o], od_ret_bias[o], od_w_out[o])
        x = x + memory_cross_attention(rms_norm(x, xa_norm[layer]), mem, xa_mem_norm[layer],
                                       xa_wq[layer], xa_wkv[layer], xa_wo[layer])
    return rms_norm(x, final_norm)
```

```cpp
#include <hip/hip_runtime.h>
#include <cstdio>
#include <cstdint>
#include <math.h>

#define LAS __attribute__((address_space(3)))
#define GAS __attribute__((address_space(1)))
typedef unsigned short bf16_t;
typedef short bf16x8 __attribute__((ext_vector_type(8)));
typedef float f32x4 __attribute__((ext_vector_type(4)));
typedef float f32x2 __attribute__((ext_vector_type(2)));
typedef unsigned u32x4 __attribute__((ext_vector_type(4)));
typedef unsigned u32x2 __attribute__((ext_vector_type(2)));
typedef __bf16 bf16x2_t __attribute__((ext_vector_type(2)));

constexpr int DM = 1024, SEQ = 2048, NB = 8, MEML = 256, HD = 128, MROWS = NB * SEQ;
constexpr float EPS = 1e-6f;
constexpr float QK_SCALE = 0.08838834764831845f;
constexpr float LOG2E = 1.4426950408889634f;

constexpr size_t MiB = 1u << 20;
constexpr size_t WS_CTL = 0, CTL_ZERO_BYTES = 1 * MiB;
constexpr size_t WS_WEIN = 1 * MiB;
constexpr size_t WS_WOIN = 17 * MiB;
constexpr size_t WS_WEOUT = 29 * MiB;
constexpr size_t WS_WOOUT = 33 * MiB;
constexpr size_t WS_WXQ = 37 * MiB;
constexpr size_t WS_WXKV = 39 * MiB;
constexpr size_t WS_WXO = 43 * MiB;
constexpr size_t WS_WRG = 45 * MiB;
constexpr size_t WS_XAKV = 46 * MiB;
constexpr size_t WS_MISC = 54 * MiB;
constexpr size_t WS_MN = 55 * MiB;
constexpr size_t WS_XB = 63 * MiB;
constexpr size_t WS_H0 = 95 * MiB, WS_H1 = 127 * MiB, WS_H2 = 159 * MiB, WS_Y = 191 * MiB;
constexpr size_t WS_ST = 223 * MiB;
constexpr size_t WS_END = 255 * MiB;
constexpr size_t HSTRIDE = 32 * MiB / 2;
constexpr int CW_BAR = 4096;
constexpr size_t CTL_KMS = 512 * 1024;
constexpr size_t CTL_SSQ = 256 * 1024;

constexpr int RING_BYTES = 131072, MISC_OFF = RING_BYTES + 320, PTR_OFF = RING_BYTES + 512  , GD_OFF = RING_BYTES + 1024  , LDS_BYTES = 147456;
constexpr int NWAVES = 8, NTHR = 512;

#define __hip_atomic_fetch_add_(p, v) (void)__hip_atomic_fetch_add((p), (v), __ATOMIC_RELAXED, __HIP_MEMORY_SCOPE_AGENT)
#define RLX_AGENT __ATOMIC_RELAXED, __HIP_MEMORY_SCOPE_AGENT
#define LDS_WAIT() asm volatile("s_waitcnt lgkmcnt(0)" ::: "memory")
__device__ __forceinline__ unsigned pk2(float lo, float hi) { f32x2 v = {lo, hi}; bf16x2_t b = __builtin_convertvector(v, bf16x2_t); return __builtin_bit_cast(unsigned, b); }
__device__ __forceinline__ float bf2f(bf16_t v) { return __uint_as_float(((unsigned)v) << 16); }
__device__ __forceinline__ bf16_t f2bf(float f) { return (bf16_t)(pk2(f, 0.f) & 0xffffu); }
typedef unsigned long long u64;
__device__ __forceinline__ unsigned uni32(unsigned v) { return (unsigned)__builtin_amdgcn_readfirstlane((int)v); }
__device__ __forceinline__ u64 uni64(u64 v) { return ((u64)uni32((unsigned)(v >> 32)) << 32) | uni32((unsigned)v); }
__device__ __forceinline__ float unif(float v) { return __uint_as_float(uni32(__float_as_uint(v))); }
__device__ __forceinline__ void lds_barrier() { asm volatile("s_waitcnt lgkmcnt(0)" ::: "memory"); __builtin_amdgcn_s_barrier(); asm volatile("" ::: "memory"); }
__device__ __forceinline__ float wave_sum(float v) {
#pragma unroll
    for (int o = 1; o < 64; o <<= 1) v += __shfl_xor(v, o);
    return v;
}
__device__ __forceinline__ float wave_max(float v) {
#pragma unroll
    for (int o = 1; o < 64; o <<= 1) v = fmaxf(v, __shfl_xor(v, o));
    return v;
}
__device__ __forceinline__ float sigmoidf_(float x) { return __builtin_amdgcn_rcpf(1.f + __expf(-x)); }
__device__ __forceinline__ float siluf_(float x) { return x * __builtin_amdgcn_rcpf(1.f + __expf(-x)); }

namespace pg8 {
constexpr int BM = 256, BK = 64, HALF = 128, HTB = HALF * BK * 2, STAGE_BYTES = 8 * HTB, NXCD = 8, WGM = 8;
__device__ __forceinline__ int lds_byte(int r, int c) { const int st = (r >> 4) * 2 + (c >> 5), rr = r & 15, cc = c & 31, ob = rr * 64 + cc * 2; return st * 1024 + (ob ^ (((ob >> 9) & 1) << 5)); }
__device__ __forceinline__ void stage_rc(int b, int& R, int& C) { const int st = b / 1024, sb = b % 1024, swz = sb ^ (((sb >> 9) & 1) << 5); R = (st >> 1) * 16 + swz / 64; C = (st & 1) * 32 + (swz % 64) / 2; }
__device__ __forceinline__ int perm32(int rho) { const int n = rho >> 4, i = rho & 15; return 8 * (i >> 2) + 4 * n + (i & 3); }

struct Unit { int g, pm, pn; };
struct GD {
    const GAS bf16_t* A; const GAS bf16_t* Bt; int nM, nN;
    int kind;
    GAS bf16_t* O; int ldc; int split_cols; long split_stride; int silu_t;
    const GAS float* ssq_r; float scale;
    const GAS float* base; GAS float* out; GAS bf16_t* xb; GAS float* ssq_w; int nunits; int diag; const GAS float* rope; GAS float* kms; int zshift; int pad2_;
};
struct Sched {
    int G, c;
    __device__ __forceinline__ bool next(int i, Unit& u, const LAS GD* gd) const {
        const int n0 = (int)uni32((unsigned)gd[0].nunits), n1 = (int)uni32((unsigned)gd[1].nunits);
        if ((int)uni32((unsigned)gd[0].zshift) < 0) {
            long Lp = (long)(i >> 1) * G + c; if (Lp >= (long)n0) return false;
            u.g = i & 1; int wgid = (int)Lp; const int nM = (int)uni32((unsigned)gd[0].nM), nN = (int)uni32((unsigned)gd[0].nN);
            { const int q = n0 / NXCD, r = n0 % NXCD, xcd = wgid % NXCD, off = wgid / NXCD; wgid = (xcd < r ? xcd * (q + 1) : r * (q + 1) + (xcd - r) * q) + off; }
            const int nig = WGM * nN, gid = wgid / nig, fm = gid * WGM, gsz = (nM - fm) < WGM ? (nM - fm) : WGM;
            u.pm = fm + ((wgid % nig) % gsz); u.pn = (wgid % nig) / gsz; return true;
        }
        long L = (long)i * G + c; if (L >= (long)(n0 + n1)) return false;
        const int g = (L >= n0) ? 1 : 0; u.g = g;
        int wgid = (int)L - (g ? n0 : 0); const int nwg = g ? n1 : n0, nM = (int)uni32((unsigned)gd[g].nM), nN = (int)uni32((unsigned)gd[g].nN);
        { const int q = nwg / NXCD, r = nwg % NXCD, xcd = wgid % NXCD, off = wgid / NXCD; wgid = (xcd < r ? xcd * (q + 1) : r * (q + 1) + (xcd - r) * q) + off; }
        if (g && (int)uni32((unsigned)gd[1].diag)) { const int l = wgid >> 5, r = wgid & 31; u.pm = l * 8 + (r & 7); u.pn = l * 4 + (r >> 3); return true; }
        const int nig = WGM * nN, gid = wgid / nig, fm = gid * WGM, gsz = (nM - fm) < WGM ? (nM - fm) : WGM;
        u.pm = fm + ((wgid % nig) % gsz); u.pn = (wgid % nig) / gsz; return true;
    }
};

template <bool BASE16  , bool WOUT  >
__device__ __forceinline__ void epilogue(const f32x4 (&acc)[2][2][4][2], const LAS GD* dl, const Unit& u, int wr, int wc, int fr, int fq) {
    GD d;
    d.kind = (int)uni32((unsigned)dl->kind);
    if (d.kind == 0) { d.O = (GAS bf16_t*)uni64((u64)dl->O); d.ldc = (int)uni32((unsigned)dl->ldc); d.split_cols = (int)uni32((unsigned)dl->split_cols); d.split_stride = (long)uni64((u64)dl->split_stride);
        d.silu_t = (int)uni32((unsigned)dl->silu_t); d.ssq_r = (const GAS float*)uni64((u64)dl->ssq_r); d.scale = unif(dl->scale); d.rope = (const GAS float*)uni64((u64)dl->rope); d.kms = (GAS float*)uni64((u64)dl->kms); d.zshift = (int)uni32((unsigned)dl->zshift); }
    else { d.base = (const GAS float*)uni64((u64)dl->base); d.out = (GAS float*)uni64((u64)dl->out); d.xb = (GAS bf16_t*)uni64((u64)dl->xb); d.ssq_w = (GAS float*)uni64((u64)dl->ssq_w); }
    const int row0 = u.pm * BM + wr * 64 + fr;
    if (d.kind == 0) {
        int colt = u.pn * BM; GAS bf16_t* base = d.O; bool act = false; int tsp = -1;
        if (d.split_cols) { const int t = colt / d.split_cols; base += (size_t)t * d.split_stride; colt -= t * d.split_cols; act = (t == d.silu_t); tsp = t; if (act) base += (size_t)d.zshift * d.split_stride; }
        const int col0 = colt + wc * 32 + 8 * fq;
        const bool do_rope = (d.rope != nullptr) && (tsp == 0 || tsp == 1) && (wc == 0);
        const bool do_km = (d.rope != nullptr) && (tsp == 1);
        float cs_[2][2][4];
#pragma unroll
        for (int bj = 0; bj < 2; ++bj)
#pragma unroll
            for (int n = 0; n < 2; ++n)
#pragma unroll
                for (int e = 0; e < 4; ++e) cs_[bj][n][e] = 0.f;
        float rsv[8];
        { const GAS float* sq_ = d.ssq_r ? d.ssq_r : (const GAS float*)d.O;
#pragma unroll
          for (int it = 0; it < 8; ++it) rsv[it] = sq_[row0 + (it >> 2) * HALF + (it & 3) * 16];
          const bool hs_ = d.ssq_r != nullptr;
#pragma unroll
          for (int it = 0; it < 8; ++it) { const float r_ = d.scale * rsqrtf(fabsf(rsv[it]) * (1.f / 1024.f) + EPS); rsv[it] = hs_ ? r_ : d.scale; } }
#define EPI0_ROWS(ROPE_) do { \
        f32x4 tcn[4]; \
        if (ROPE_) { const GAS f32x4* tp = (const GAS f32x4*)(d.rope + (size_t)row0 * 32 + 16 * (fq & 1)); \
_Pragma("unroll") \
            for (int q4 = 0; q4 < 4; ++q4) tcn[q4] = tp[q4]; } \
_Pragma("unroll") \
        for (int ai = 0; ai < 2; ++ai) \
_Pragma("unroll") \
            for (int m = 0; m < 4; ++m) { \
                const int row = row0 + ai * HALF + m * 16; \
                const float rs = rsv[ai * 4 + m]; \
                GAS bf16_t* rowp = base + (size_t)row * d.ldc + col0; \
                f32x4 tc[4]; \
                if (ROPE_) { \
_Pragma("unroll") \
                    for (int q4 = 0; q4 < 4; ++q4) tc[q4] = tcn[q4]; \
                    if (ai * 4 + m < 7) { const int rown = row0 + ((ai * 4 + m + 1) >> 2) * HALF + ((ai * 4 + m + 1) & 3) * 16; const GAS f32x4* tp = (const GAS f32x4*)(d.rope + (size_t)rown * 32 + 16 * (fq & 1)); \
_Pragma("unroll") \
                        for (int q4 = 0; q4 < 4; ++q4) tcn[q4] = tp[q4]; } } \
_Pragma("unroll") \
                for (int bj = 0; bj < 2; ++bj) { \
                    f32x4 v0 = acc[ai][bj][m][0] * rs, v1 = acc[ai][bj][m][1] * rs; \
                    if (act) { \
_Pragma("unroll") \
                        for (int e = 0; e < 4; ++e) { v0[e] = siluf_(v0[e]); v1[e] = siluf_(v1[e]); } \
                    } \
                    if (ROPE_) { \
                        const float sg = (fq < 2) ? -1.f : 1.f; \
_Pragma("unroll") \
                        for (int e = 0; e < 4; ++e) { \
                            const float p0 = __shfl_xor(v0[e], 32), p1 = __shfl_xor(v1[e], 32); \
                            const float c0 = tc[e >> 1][2 * (e & 1)], s0 = tc[e >> 1][2 * (e & 1) + 1], c1 = tc[2 + (e >> 1)][2 * (e & 1)], s1 = tc[2 + (e >> 1)][2 * (e & 1) + 1]; \
                            v0[e] = v0[e] * c0 + sg * p0 * s0; v1[e] = v1[e] * c1 + sg * p1 * s1; \
                        } \
                    } \
                    if (do_km) { \
_Pragma("unroll") \
                        for (int e = 0; e < 4; ++e) { cs_[bj][0][e] += v0[e]; cs_[bj][1][e] += v1[e]; } \
                    } \
                    u32x4 w; w.x = pk2(v0[0], v0[1]); w.y = pk2(v0[2], v0[3]); w.z = pk2(v1[0], v1[1]); w.w = pk2(v1[2], v1[3]); \
                    *(GAS u32x4*)(rowp + bj * HALF) = w; \
                } \
            } \
        } while (0)
        if (do_rope) EPI0_ROWS(true); else EPI0_ROWS(false);
#undef EPI0_ROWS
        if (do_km) {
            GAS float* kp = d.kms + (size_t)u.pm * DM + colt + wc * 32 + 8 * fq;
#pragma unroll
            for (int bj = 0; bj < 2; ++bj)
#pragma unroll
                for (int n = 0; n < 2; ++n)
#pragma unroll
                    for (int e = 0; e < 4; ++e) { float v = cs_[bj][n][e]; v += __shfl_xor(v, 1); v += __shfl_xor(v, 2); v += __shfl_xor(v, 4); v += __shfl_xor(v, 8);
                        if (fr == 0) __hip_atomic_fetch_add_(kp + bj * HALF + 4 * n + e, v); }
        }
    } else {
        const int col0 = u.pn * BM + wc * 32 + 8 * fq;
        f32x4 bq[3][2][2] = {};
#define EPI_BLOAD(set_, it_) do { const size_t offn_ = (size_t)(row0 + ((it_) >> 2) * HALF + ((it_) & 3) * 16) * DM + col0; \
            _Pragma("unroll") for (int bj = 0; bj < 2; ++bj) { \
                if (BASE16) { const u32x4 w_ = *(const GAS u32x4*)((const GAS bf16_t*)d.base + offn_ + bj * HALF); bq[set_][bj][0] = __builtin_bit_cast(f32x4, w_); } \
                else { bq[set_][bj][0] = *(const GAS f32x4*)(d.base + offn_ + bj * HALF); bq[set_][bj][1] = *(const GAS f32x4*)(d.base + offn_ + bj * HALF + 4); } } } while (0)
        EPI_BLOAD(0, 0); EPI_BLOAD(1, 1);
#pragma unroll
        for (int ai = 0; ai < 2; ++ai)
#pragma unroll
            for (int m = 0; m < 4; ++m) {
                const int row = row0 + ai * HALF + m * 16;
                const size_t off = (size_t)row * DM + col0;
                float s = 0.f;
                f32x4 bc[2][2];
#pragma unroll
                for (int bj = 0; bj < 2; ++bj) { bc[bj][0] = bq[(ai * 4 + m) % 3][bj][0]; bc[bj][1] = bq[(ai * 4 + m) % 3][bj][1]; }
                if (ai * 4 + m < 6) EPI_BLOAD((ai * 4 + m + 2) % 3, ai * 4 + m + 2);
#pragma unroll
                for (int bj = 0; bj < 2; ++bj) {
                    f32x4 b0 = bc[bj][0], b1 = bc[bj][1];
                    if (BASE16) { const u32x4 w_ = __builtin_bit_cast(u32x4, bc[bj][0]);
                        b0 = (f32x4){__uint_as_float(w_.x << 16), __uint_as_float(w_.x & 0xffff0000u), __uint_as_float(w_.y << 16), __uint_as_float(w_.y & 0xffff0000u)};
                        b1 = (f32x4){__uint_as_float(w_.z << 16), __uint_as_float(w_.z & 0xffff0000u), __uint_as_float(w_.w << 16), __uint_as_float(w_.w & 0xffff0000u)}; }
                    const f32x4 v0 = acc[ai][bj][m][0] + b0, v1 = acc[ai][bj][m][1] + b1;
                    if (WOUT) { *(GAS f32x4*)(d.out + off + bj * HALF) = v0; *(GAS f32x4*)(d.out + off + bj * HALF + 4) = v1; }
                    if (d.kind == 2) {
                        u32x4 w; w.x = pk2(v0[0], v0[1]); w.y = pk2(v0[2], v0[3]); w.z = pk2(v1[0], v1[1]); w.w = pk2(v1[2], v1[3]);
                        *(GAS u32x4*)(d.xb + off + bj * HALF) = w;
                        s += (v0[0] * v0[0] + v0[1] * v0[1]) + (v0[2] * v0[2] + v0[3] * v0[3]) + (v1[0] * v1[0] + v1[1] * v1[1]) + (v1[2] * v1[2] + v1[3] * v1[3]);
                    }
                }
                if (d.kind == 2) {
                    s += __shfl_xor(s, 16); s += __shfl_xor(s, 32);
                    if (fq == 0) __hip_atomic_fetch_add_(d.ssq_w + row, s);
                }
                asm volatile("" ::: "memory");
            }
#undef EPI_BLOAD
    }
}

__device__ __forceinline__ void epilogue_fin(f32x4 (&acc)[2][2][4][2], const LAS GD* dl, const Unit& u, int wr, int wc, int fr, int fq) {
    GD d;
    d.base = (const GAS float*)uni64((u64)dl->base); d.out = (GAS float*)uni64((u64)dl->out); d.ssq_w = (GAS float*)uni64((u64)dl->ssq_w);
    d.ssq_r = (const GAS float*)uni64((u64)dl->ssq_r); d.kms = (GAS float*)uni64((u64)dl->kms);
    const int row0 = u.pm * BM + wr * 64 + fr;
    {
        const unsigned col0 = (unsigned)(u.pn * BM + wc * 32 + 8 * fq), off0 = (unsigned)row0 * DM + col0;
        u32x4 bn[2];
#pragma unroll
        for (int bj = 0; bj < 2; ++bj) bn[bj] = *(const GAS u32x4*)((const GAS bf16_t*)d.base + (off0 + bj * HALF));
#pragma unroll
        for (int ai = 0; ai < 2; ++ai)
#pragma unroll
            for (int m = 0; m < 4; ++m) {
                float s_ = 0.f;
                u32x4 bc[2];
#pragma unroll
                for (int bj = 0; bj < 2; ++bj) bc[bj] = bn[bj];
                if (ai * 4 + m < 7) { const unsigned offn = off0 + (unsigned)(((ai * 4 + m + 1) >> 2) * HALF + ((ai * 4 + m + 1) & 3) * 16) * DM;
#pragma unroll
                    for (int bj = 0; bj < 2; ++bj) bn[bj] = *(const GAS u32x4*)((const GAS bf16_t*)d.base + (offn + bj * HALF)); }
#pragma unroll
                for (int bj = 0; bj < 2; ++bj) {
                    const u32x4 w_ = bc[bj];
                    const f32x4 b0 = (f32x4){__uint_as_float(w_.x << 16), __uint_as_float(w_.x & 0xffff0000u), __uint_as_float(w_.y << 16), __uint_as_float(w_.y & 0xffff0000u)};
                    const f32x4 b1 = (f32x4){__uint_as_float(w_.z << 16), __uint_as_float(w_.z & 0xffff0000u), __uint_as_float(w_.w << 16), __uint_as_float(w_.w & 0xffff0000u)};
                    f32x4 v0 = acc[ai][bj][m][0] + b0, v1 = acc[ai][bj][m][1] + b1;
                    asm volatile("" : "+v"(v0), "+v"(v1));
                    s_ += (v0[0] * v0[0] + v0[1] * v0[1]) + (v0[2] * v0[2] + v0[3] * v0[3]) + (v1[0] * v1[0] + v1[1] * v1[1]) + (v1[2] * v1[2] + v1[3] * v1[3]);
                    acc[ai][bj][m][0] = v0; acc[ai][bj][m][1] = v1;
                }
                s_ += __shfl_xor(s_, 16); s_ += __shfl_xor(s_, 32);
                if (fq == 0) __hip_atomic_fetch_add_(d.ssq_w + (unsigned)(row0 + ai * HALF + m * 16), s_);
                asm volatile("" ::: "memory");
            }
        asm volatile("s_waitcnt vmcnt(0)" ::: "memory");
        __syncthreads();
        if (wr == 0 && wc == 0 && fr == 0 && fq == 0) {
            GAS unsigned* cnt = (GAS unsigned*)d.kms + 16 * u.pm;
            __builtin_amdgcn_fence(__ATOMIC_RELEASE, "agent"); asm volatile("s_waitcnt vmcnt(0)" ::: "memory");
            (void)__hip_atomic_fetch_add(cnt, 1u, __ATOMIC_RELAXED, __HIP_MEMORY_SCOPE_AGENT);
            unsigned sp_ = 0u; while (__hip_atomic_load(cnt, __ATOMIC_RELAXED, __HIP_MEMORY_SCOPE_AGENT) < 4u && ++sp_ < (1u << 22)) __builtin_amdgcn_s_sleep(1);
            __builtin_amdgcn_fence(__ATOMIC_ACQUIRE, "agent"); asm volatile("s_waitcnt vmcnt(0)" ::: "memory");
        }
        __syncthreads();
        f32x4 gm[2][2]; float rsv[8];
#pragma unroll
        for (int bj = 0; bj < 2; ++bj) { gm[bj][0] = *(const GAS f32x4*)(d.ssq_r + (col0 + bj * HALF)); gm[bj][1] = *(const GAS f32x4*)(d.ssq_r + (col0 + bj * HALF + 4)); }
#pragma unroll
        for (int it = 0; it < 8; ++it) rsv[it] = __hip_atomic_load(d.ssq_w + (unsigned)(row0 + (it >> 2) * HALF + (it & 3) * 16), __ATOMIC_RELAXED, __HIP_MEMORY_SCOPE_AGENT);
#pragma unroll
        for (int it = 0; it < 8; ++it) rsv[it] = rsqrtf(rsv[it] * (1.f / 1024.f) + EPS);
#pragma unroll
        for (int ai = 0; ai < 2; ++ai)
#pragma unroll
            for (int m = 0; m < 4; ++m) {
                const unsigned off = off0 + (unsigned)(ai * HALF + m * 16) * DM;
                const float rs = rsv[ai * 4 + m];
#pragma unroll
                for (int bj = 0; bj < 2; ++bj) {
                    *(GAS f32x4*)(d.out + (off + bj * HALF)) = acc[ai][bj][m][0] * rs * gm[bj][0]; *(GAS f32x4*)(d.out + (off + bj * HALF + 4)) = acc[ai][bj][m][1] * rs * gm[bj][1]; }
            }
    }
}

template <bool ALIGN_EPI, bool SP2, bool FUSE_FIN = false, bool BASE16 = false, bool WOUT = true>
__device__ __forceinline__ void gemm_phase(LAS unsigned char* lds, const int K, const Sched& S, const LAS GD* gd, const int tid) {
    const int wid = __builtin_amdgcn_readfirstlane(tid >> 6), lane = tid & 63, wr = wid >> 2, wc = wid & 3, fr = lane & 15, fq = lane >> 4;
    const int nt = K / BK;
    unsigned voffA[2], voffB[2];
#pragma unroll
    for (int i = 0; i < 2; ++i) { int R, C; stage_rc(tid * 16 + i * 8192, R, C); const int Rb = (R & ~31) + perm32(R & 31);
        voffA[i] = (unsigned)(R * K + C) * 2u; voffB[i] = (unsigned)(Rb * K + C) * 2u; }
    const size_t kstep = (size_t)(BK * 2);
    const size_t hstep = (size_t)HALF * K * 2;
    const size_t tstep = 2 * hstep;
    const unsigned ldsw = (unsigned)wid * 1024u;
    const int aoff = lds_byte(wr * 64 + fr, fq * 8), boff = lds_byte(wc * 32 + fr, fq * 8);
#define PG8_SA(b, h) (((b) * 2 + (h)) * HTB)
#define PG8_SB(b, h) ((4 + (b) * 2 + (h)) * HTB)
#define PG8_STAGE(bufoff, gbase, voff) do { _Pragma("unroll") for (int _i = 0; _i < 2; ++_i) \
        __builtin_amdgcn_global_load_lds((const GAS unsigned*)((const char*)(gbase) + (voff)[_i]), (LAS unsigned*)(lds + (bufoff) + ldsw + _i * 8192), 16, 0, 0); } while (0)
#define PG8_LDA(dst, b, h) do { _Pragma("unroll") for (int m = 0; m < 4; ++m) _Pragma("unroll") for (int k = 0; k < 2; ++k) dst[m][k] = *(const LAS bf16x8*)(lds + PG8_SA(b, h) + aoff + m * 2048 + k * 1024); } while (0)
#define PG8_LDB(dst, b, h) do { _Pragma("unroll") for (int n = 0; n < 2; ++n) _Pragma("unroll") for (int k = 0; k < 2; ++k) dst[n][k] = *(const LAS bf16x8*)(lds + PG8_SB(b, h) + boff + n * 2048 + k * 1024); } while (0)
#define PG8_MMA(ai, bj, At, Bt) do { __builtin_amdgcn_s_setprio(1); _Pragma("unroll") for (int m = 0; m < 4; ++m) _Pragma("unroll") for (int n = 0; n < 2; ++n) _Pragma("unroll") for (int k = 0; k < 2; ++k) \
        acc[ai][bj][m][n] = __builtin_amdgcn_mfma_f32_16x16x32_bf16(Bt[n][k], At[m][k], acc[ai][bj][m][n], 0, 0, 0); __builtin_amdgcn_s_setprio(0); } while (0)
#define PG8_WAIT_V(n) asm volatile("s_waitcnt vmcnt(" #n ")" ::: "memory")
#define PG8_WAIT_L(n) asm volatile("s_waitcnt lgkmcnt(" #n ")" ::: "memory")
#define PG8_BAR __builtin_amdgcn_s_barrier()
#define PG8_SCHED __builtin_amdgcn_sched_barrier(0)
#define PG8_UA(u) ((const char*)uni64((u64)gd[(u).g].A) + (size_t)(u).pm * tstep)
#define PG8_UB(u) ((const char*)uni64((u64)gd[(u).g].Bt) + (size_t)(u).pn * tstep)
    Unit cur, nxt; int ui = 0; bool fin_pend = false;
    if (!S.next(0, cur, gd)) return;
    f32x4 acc[2][2][4][2];
#pragma unroll
    for (int a = 0; a < 2; ++a)
#pragma unroll
        for (int b = 0; b < 2; ++b)
#pragma unroll
            for (int m = 0; m < 4; ++m)
#pragma unroll
                for (int n = 0; n < 2; ++n) acc[a][b][m][n] = (f32x4){0.f, 0.f, 0.f, 0.f};
    bf16x8 At[4][2], B0[2][2], B1[2][2];
    const char* cA = PG8_UA(cur); const char* cB = PG8_UB(cur);
    if constexpr (SP2) {
        PG8_STAGE(PG8_SB(0, 0), cB, voffB); PG8_STAGE(PG8_SB(0, 1), cB + hstep, voffB); PG8_STAGE(PG8_SA(0, 0), cA, voffA); PG8_STAGE(PG8_SA(0, 1), cA + hstep, voffA);
        if (wr == 1) PG8_BAR;
        PG8_WAIT_V(2); PG8_BAR;
        PG8_STAGE(PG8_SB(1, 0), cB + kstep, voffB); PG8_STAGE(PG8_SA(1, 0), cA + kstep, voffA); PG8_STAGE(PG8_SB(1, 1), cB + hstep + kstep, voffB);
        PG8_WAIT_V(6); PG8_BAR;
    } else {
        PG8_STAGE(PG8_SB(0, 0), cB, voffB); PG8_STAGE(PG8_SA(0, 0), cA, voffA); PG8_STAGE(PG8_SB(0, 1), cB + hstep, voffB); PG8_STAGE(PG8_SA(0, 1), cA + hstep, voffA);
        if (wr == 1) PG8_BAR;
        PG8_WAIT_V(4); PG8_BAR;
        PG8_STAGE(PG8_SB(1, 0), cB + kstep, voffB); PG8_STAGE(PG8_SA(1, 0), cA + kstep, voffA); PG8_STAGE(PG8_SB(1, 1), cB + hstep + kstep, voffB);
        PG8_WAIT_V(6); PG8_BAR;
    }
    for (;;) {
        const bool has_next = S.next(ui + 1, nxt, gd);
        const char* nA = has_next ? PG8_UA(nxt) : cA; const char* nB = has_next ? PG8_UB(nxt) : cB;
        for (int t = 0; t < nt; t += 2) {
            const bool last = (t == nt - 2);
            const char* a1 = cA + (size_t)(t + 1) * kstep;
            const char* a2 = last ? nA : cA + (size_t)(t + 2) * kstep; const char* b2 = last ? nB : cB + (size_t)(t + 2) * kstep;
            const char* a3 = a2 + kstep; const char* b3 = b2 + kstep;
            if constexpr (SP2) {
            PG8_LDB(B0, 0, 0); PG8_LDB(B1, 0, 1); PG8_SCHED; PG8_LDA(At, 0, 0); PG8_STAGE(PG8_SA(1, 1), a1 + hstep, voffA);
            PG8_WAIT_V(8); PG8_WAIT_L(0); PG8_BAR; PG8_MMA(0, 0, At, B0); PG8_MMA(0, 1, At, B1); PG8_BAR; PG8_SCHED;
            PG8_LDA(At, 0, 1); PG8_STAGE(PG8_SB(0, 0), b2, voffB); PG8_STAGE(PG8_SB(0, 1), b2 + hstep, voffB); PG8_STAGE(PG8_SA(0, 0), a2, voffA);
            PG8_WAIT_V(8); PG8_WAIT_L(0); PG8_BAR; PG8_MMA(1, 0, At, B0); PG8_MMA(1, 1, At, B1); PG8_BAR; PG8_SCHED;
            PG8_LDB(B0, 1, 0); PG8_LDB(B1, 1, 1); PG8_SCHED; PG8_LDA(At, 1, 0); PG8_STAGE(PG8_SA(0, 1), a2 + hstep, voffA);
            PG8_WAIT_V(8); PG8_WAIT_L(0); PG8_BAR; PG8_MMA(0, 0, At, B0); PG8_MMA(0, 1, At, B1); PG8_BAR; PG8_SCHED;
            PG8_LDA(At, 1, 1); PG8_STAGE(PG8_SB(1, 0), b3, voffB); PG8_STAGE(PG8_SB(1, 1), b3 + hstep, voffB); PG8_STAGE(PG8_SA(1, 0), a3, voffA);
            PG8_WAIT_V(8); PG8_WAIT_L(0); PG8_BAR; PG8_MMA(1, 0, At, B0); PG8_MMA(1, 1, At, B1); PG8_BAR; PG8_SCHED;
            } else {
            PG8_LDB(B0, 0, 0); PG8_SCHED; PG8_LDA(At, 0, 0); PG8_STAGE(PG8_SA(1, 1), a1 + hstep, voffA);
            PG8_WAIT_L(8); PG8_BAR; PG8_WAIT_L(0); PG8_MMA(0, 0, At, B0); PG8_BAR; PG8_SCHED;
            PG8_LDB(B1, 0, 1); PG8_STAGE(PG8_SB(0, 0), b2, voffB);
            PG8_BAR; PG8_WAIT_L(0); PG8_MMA(0, 1, At, B1); PG8_BAR;
            PG8_LDA(At, 0, 1); PG8_STAGE(PG8_SA(0, 0), a2, voffA);
            PG8_BAR; PG8_WAIT_L(0); PG8_MMA(1, 0, At, B0); PG8_BAR; PG8_SCHED;
            PG8_STAGE(PG8_SB(0, 1), b2 + hstep, voffB);
            PG8_WAIT_V(6); PG8_BAR; PG8_MMA(1, 1, At, B1); PG8_BAR;
            PG8_LDB(B0, 1, 0); PG8_SCHED; PG8_LDA(At, 1, 0); PG8_STAGE(PG8_SA(0, 1), a2 + hstep, voffA);
            PG8_WAIT_L(8); PG8_BAR; PG8_WAIT_L(0); PG8_MMA(0, 0, At, B0); PG8_BAR; PG8_SCHED;
            PG8_LDB(B1, 1, 1); PG8_STAGE(PG8_SB(1, 0), b3, voffB);
            PG8_BAR; PG8_WAIT_L(0); PG8_MMA(0, 1, At, B1); PG8_BAR;
            PG8_LDA(At, 1, 1); PG8_STAGE(PG8_SA(1, 0), a3, voffA);
            PG8_BAR; PG8_WAIT_L(0); PG8_MMA(1, 0, At, B0); PG8_BAR; PG8_SCHED;
            PG8_STAGE(PG8_SB(1, 1), b3 + hstep, voffB);
            PG8_WAIT_V(6); PG8_BAR; PG8_MMA(1, 1, At, B1); PG8_BAR;
            }
        }
        const bool epi = (int)uni32((unsigned)gd[cur.g].kind) >= 0;
        if (epi) {
            if constexpr (ALIGN_EPI) { if (wr == 0) PG8_BAR; }
            if (FUSE_FIN && (int)uni32((unsigned)gd[cur.g].kind) == 4) fin_pend = true;
            else {
                epilogue<BASE16, WOUT>(acc, gd + cur.g, cur, wr, wc, fr, fq);
#pragma unroll
                for (int a = 0; a < 2; ++a)
#pragma unroll
                    for (int b = 0; b < 2; ++b)
#pragma unroll
                        for (int m = 0; m < 4; ++m)
#pragma unroll
                            for (int n = 0; n < 2; ++n) acc[a][b][m][n] = (f32x4){0.f, 0.f, 0.f, 0.f};
            }
        }
        if (!has_next) break;
        cur = nxt; cA = nA; cB = nB; ++ui;
        if (epi) { if constexpr (ALIGN_EPI) { if (wr == 1) PG8_BAR; } }
    }
    PG8_WAIT_V(0);
    if constexpr (!ALIGN_EPI) { if (wr == 0) PG8_BAR; }
    PG8_BAR;
    if constexpr (FUSE_FIN) { if (fin_pend) epilogue_fin(acc, gd + cur.g, cur, wr, wc, fr, fq); }
#undef PG8_SA
#undef PG8_SB
#undef PG8_STAGE
#undef PG8_LDA
#undef PG8_LDB
#undef PG8_MMA
#undef PG8_WAIT_V
#undef PG8_WAIT_L
#undef PG8_BAR
#undef PG8_SCHED
#undef PG8_UA
#undef PG8_UB
}
}

#define XB_TMO      128
#define XB_XCNT(j)  (256  + 64 * (j))
#define XB_XSUB(j)  (1280 + 64 * (j))
#define XB_XGEN(j)  (2304 + 64 * (j))
#define XB_TOP      3328
#define XB_TOPGEN   3392
#define XCD_BAR_WORDS 3456
#define XB_SPIN_CAP (1u << 18)
__device__ __forceinline__ unsigned xb_ld(GAS unsigned* p)              { return __hip_atomic_load(p, __ATOMIC_RELAXED, __HIP_MEMORY_SCOPE_AGENT); }
__device__ __forceinline__ unsigned xb_add(GAS unsigned* p, unsigned v) { return __hip_atomic_fetch_add(p, v, __ATOMIC_RELAXED, __HIP_MEMORY_SCOPE_AGENT); }
__device__ __forceinline__ unsigned xb_xcc_id() { return (unsigned)__builtin_amdgcn_s_getreg((3 << 11) | 20) & 0xFu; }
#define XB_SPIN(cond, bar) do { unsigned _sp = 0; while (cond) { __builtin_amdgcn_s_sleep(1); \
    if ((++_sp & 255u) == 0u) { if (xb_ld(&(bar)[XB_TMO])) break; if (_sp > XB_SPIN_CAP) { __hip_atomic_fetch_add_(&(bar)[XB_TMO], 1u); break; } } } } while (0)
struct XcdBarrier { GAS unsigned* bar; unsigned x; volatile LAS unsigned* st; int wave; };
__device__ __forceinline__ XcdBarrier xcd_barrier_post(GAS unsigned* bar, volatile LAS unsigned* st) {
    XcdBarrier b; b.bar = bar; b.x = xb_xcc_id(); b.st = st;
    if (threadIdx.x == 0) (void)xb_add(&bar[XB_XCNT(b.x)], 1u);
    return b;
}
__device__ __forceinline__ void xcd_barrier_complete(GAS unsigned* bar, unsigned x, unsigned& nloc, unsigned& nx) {
    const unsigned G = gridDim.x * gridDim.y * gridDim.z;
    unsigned sum, cnt, mine, sp = 0u;
    for (;;) {
        sum = 0u; cnt = 0u; mine = 0u;
#pragma unroll
        for (unsigned j = 0; j < 16; ++j) { const unsigned c = xb_ld(&bar[XB_XCNT(j)]); sum += c; cnt += (c > 0u) ? 1u : 0u; mine = (j == x) ? c : mine; }
        if (sum == G) break;
        __builtin_amdgcn_s_sleep(1);
        if ((++sp & 255u) == 0u) { if (xb_ld(&bar[XB_TMO])) break; if (sp > XB_SPIN_CAP) { __hip_atomic_fetch_add_(&bar[XB_TMO], 1u); break; } }
    }
    nloc = mine > 0u ? mine : 1u; nx = cnt > 0u ? cnt : 1u;
}
__device__ __forceinline__ void xcd_barrier(const XcdBarrier& b) {
    asm volatile("s_waitcnt vmcnt(0)" ::: "memory");
    __syncthreads();
    int ln; asm volatile("v_mbcnt_lo_u32_b32 %0, -1, 0\n\tv_mbcnt_hi_u32_b32 %0, -1, %0" : "=&v"(ln));
    if (b.wave == 0 && ln == 0) {
        GAS unsigned* bar = b.bar; asm volatile("" : "+s"(bar));
        __builtin_amdgcn_s_waitcnt(0);
        unsigned nloc = b.st[0], nx = b.st[1];
        if (nloc == 0u) { xcd_barrier_complete(bar, b.x, nloc, nx); b.st[0] = nloc; b.st[1] = nx; }
        const unsigned old = xb_add(&bar[XB_XSUB(b.x)], 1u);
        const unsigned gen = old / nloc;
        if (old + 1u == (gen + 1u) * nloc) {
            __builtin_amdgcn_fence(__ATOMIC_RELEASE, "agent");
            asm volatile("s_waitcnt vmcnt(0)" ::: "memory");
            const unsigned og = xb_add(&bar[XB_TOP], 1u);
            const unsigned tg = og / nx;
            if (og + 1u == (tg + 1u) * nx) xb_add(&bar[XB_TOPGEN], 1u);
            else XB_SPIN(xb_ld(&bar[XB_TOPGEN]) == tg, bar);
            __builtin_amdgcn_fence(__ATOMIC_ACQUIRE, "agent");
            xb_add(&bar[XB_XGEN(b.x)], 1u);
            asm volatile("s_waitcnt vmcnt(0)" ::: "memory");
        } else {
            XB_SPIN(xb_ld(&bar[XB_XGEN(b.x)]) == gen, bar);
            __builtin_amdgcn_fence(__ATOMIC_ACQUIRE, "agent");
            asm volatile("s_waitcnt vmcnt(0)" ::: "memory");
        }
    }
    __syncthreads();
}

struct Args { const void* in[26]; float* out; unsigned char* ws; int ph_lo, ph_hi; };
enum { I_X = 0, I_MEM, I_POS, I_LBL, I_EVN, I_EVWIN, I_EVGAIN, I_EVWOUT, I_ODN, I_ODWIN, I_CW, I_CB, I_WA, I_BA, I_WX, I_BX, I_LAM, I_RGAIN, I_RBIAS, I_ODWOUT,
       I_XAN, I_XAMN, I_XAWQ, I_XAWKV, I_XAWO, I_FIN };

__device__ __forceinline__ void tr_item(const GAS float* W, int ldw, int k0, int nsrc, GAS bf16_t* WT, int ldt, int ndst, int kdst, const GAS float* gain, LAS float* scr, int lane) {
    const int n4 = lane & 15, kq = lane >> 4;
    f32x4 v[16];
#pragma unroll
    for (int i = 0; i < 16; ++i) v[i] = *(const GAS f32x4*)(W + (size_t)(k0 + kq + 4 * i) * ldw + nsrc + 4 * n4);
#pragma unroll
    for (int i = 0; i < 16; ++i) { const int kk = kq + 4 * i; f32x4 x = v[i]; if (gain) x = x * gain[k0 + kk];
        *(LAS f32x4*)(scr + kk * 64 + ((4 * n4 + 8 * (kk >> 3)) & 63)) = x; }
    LDS_WAIT(); asm volatile("" ::: "memory");
    const int c = lane & 7;
#pragma unroll
    for (int j = 0; j < 8; ++j) { const int n = (lane >> 3) + 8 * j; const LAS float* s = scr + (8 * c) * 64 + ((n + 8 * c) & 63);
        u32x4 o; o.x = pk2(s[0 * 64], s[1 * 64]); o.y = pk2(s[2 * 64], s[3 * 64]); o.z = pk2(s[4 * 64], s[5 * 64]); o.w = pk2(s[6 * 64], s[7 * 64]);
        *(GAS u32x4*)(WT + (size_t)(ndst + n) * ldt + kdst + 8 * c) = o; }
    LDS_WAIT(); asm volatile("" ::: "memory");
}
__device__ __forceinline__ bool tr_seg(int& r, const GAS float* W, int ldw, int K, int nsrc0, int ncols, GAS bf16_t* WT, int ndst0, const GAS float* gain, LAS float* scr, int lane) {
    const int nblk = ncols / 64, items = (K / 64) * nblk;
    if (r >= items) { r -= items; return false; }
    const int kb = r / nblk, nb = r % nblk;
    tr_item(W, ldw, 64 * kb, nsrc0 + 64 * nb, WT, K, ndst0 + 64 * nb, 64 * kb, gain, scr, lane);
    return true;
}
__device__ __forceinline__ void rms_row_bf16(const GAS float* xrow, const GAS float* gain, GAS bf16_t* orow, int lane) {
    const GAS f32x4* xr = (const GAS f32x4*)xrow + lane; const GAS f32x4* gr = (const GAS f32x4*)gain + lane;
    f32x4 v[4]; float s = 0.f;
#pragma unroll
    for (int j = 0; j < 4; ++j) { v[j] = xr[64 * j]; s += (v[j].x * v[j].x + v[j].y * v[j].y) + (v[j].z * v[j].z + v[j].w * v[j].w); }
    const float r = rsqrtf(wave_sum(s) * (1.f / DM) + EPS);
    GAS u32x2* o8 = (GAS u32x2*)orow + lane;
#pragma unroll
    for (int j = 0; j < 4; ++j) { const f32x4 g = gr[64 * j]; u32x2 w; w.x = pk2(v[j].x * r * g.x, v[j].y * r * g.y); w.y = pk2(v[j].z * r * g.z, v[j].w * r * g.w); o8[64 * j] = w; }
}

__device__ __forceinline__ void rms_row2_bf16(const GAS float* xa, const GAS float* xb, const GAS float* gain, GAS bf16_t* oa, GAS bf16_t* ob, int lane) {
    const GAS f32x4* pa = (const GAS f32x4*)xa + lane; const GAS f32x4* pb = (const GAS f32x4*)xb + lane; const GAS f32x4* gr = (const GAS f32x4*)gain + lane;
    f32x4 va[4], vb[4]; float sa = 0.f, sb = 0.f;
#pragma unroll
    for (int j = 0; j < 4; ++j) { va[j] = pa[64 * j]; vb[j] = pb[64 * j]; }
#pragma unroll
    for (int j = 0; j < 4; ++j) { sa += (va[j].x * va[j].x + va[j].y * va[j].y) + (va[j].z * va[j].z + va[j].w * va[j].w); sb += (vb[j].x * vb[j].x + vb[j].y * vb[j].y) + (vb[j].z * vb[j].z + vb[j].w * vb[j].w); }
    const float ra = rsqrtf(wave_sum(sa) * (1.f / DM) + EPS), rb = rsqrtf(wave_sum(sb) * (1.f / DM) + EPS);
    GAS u32x2* o8a = (GAS u32x2*)oa + lane; GAS u32x2* o8b = (GAS u32x2*)ob + lane;
#pragma unroll
    for (int j = 0; j < 4; ++j) { const f32x4 g = gr[64 * j]; u32x2 w; w.x = pk2(va[j].x * ra * g.x, va[j].y * ra * g.y); w.y = pk2(va[j].z * ra * g.z, va[j].w * ra * g.w); o8a[64 * j] = w;
        w.x = pk2(vb[j].x * rb * g.x, vb[j].y * rb * g.y); w.y = pk2(vb[j].z * rb * g.z, vb[j].w * rb * g.w); o8b[64 * j] = w; }
}
enum { PH_PRO = 0, PH_GEMM_A0, PH_HGRN_A, PH_HGRN, PH_GEMM_B0, PH_MOBA, PH_OUT_B0, PH_XQ0, PH_XATT0, PH_XO0,
       PH_GEMM_D1, PH_RET_A, PH_RET, PH_GEMM_C1, PH_RGLRU, PH_OUT_C1, PH_XQ1, PH_XATT1, PH_XO1, PH_FIN, PH_COUNT };

__device__ __forceinline__ const GAS void* lds_ptr(const LAS u64* p) { return (const GAS void*)uni64(*p); }
#define INP(i) ((const GAS float*)lds_ptr(ptab + (i)))
#define WSDEF GAS unsigned char* ws = (GAS unsigned char*)lds_ptr(ptab + 27); (void)ws
#define OUTDEF GAS float* out = (GAS float*)lds_ptr(ptab + 26)
#define HDEF GAS bf16_t* H0 = (GAS bf16_t*)(ws + WS_H0); GAS bf16_t* H1 = (GAS bf16_t*)(ws + WS_H1); GAS bf16_t* H2 = (GAS bf16_t*)(ws + WS_H2); GAS bf16_t* Y = (GAS bf16_t*)(ws + WS_Y); (void)H0; (void)H1; (void)H2; (void)Y


namespace att {
typedef float f32x16 __attribute__((ext_vector_type(16)));
typedef short s16x4 __attribute__((ext_vector_type(4)));
constexpr int KOFF = 0, VOFF = 32768, SCR_OFF = 65536;
__device__ __forceinline__ f32x16 mfma32(bf16x8 a, bf16x8 b, f32x16 c) { return __builtin_amdgcn_mfma_f32_32x32x16_bf16(a, b, c, 0, 0, 0); }
__device__ __forceinline__ u32x2 vtr(const LAS unsigned char* p) { return __builtin_bit_cast(u32x2, __builtin_amdgcn_ds_read_tr16_b64_v4i16((LAS s16x4*)p)); }
__device__ __forceinline__ bf16x8 cat2(u32x2 lo, u32x2 hh) { u32x4 w; w.x = lo.x; w.y = lo.y; w.z = hh.x; w.w = hh.y; return __builtin_bit_cast(bf16x8, w); }
__device__ __forceinline__ float max3f(float a, float b, float c) { float r; asm("v_max3_f32 %0, %1, %2, %3" : "=v"(r) : "v"(a), "v"(b), "v"(c)); return r; }
__device__ __forceinline__ float max2f(float a, float b) { float r; asm("v_max_f32_e32 %0, %1, %2" : "=v"(r) : "v"(a), "v"(b)); return r; }
__device__ __forceinline__ float xhalf_max(float m) { auto rr = __builtin_amdgcn_permlane32_swap(__float_as_uint(m), __float_as_uint(m), false, false); return max2f(__uint_as_float(rr[0]), __uint_as_float(rr[1])); }
__device__ __forceinline__ float xhalf_sum(float m) { auto rr = __builtin_amdgcn_permlane32_swap(__float_as_uint(m), __float_as_uint(m), false, false); return __uint_as_float(rr[0]) + __uint_as_float(rr[1]); }

template <int MODE, int KN = 4>
__device__ __forceinline__ void attn_unit(LAS unsigned char* lds, const int tid, const GAS bf16_t* Qg, const int ldq, const float sc,
                                          const GAS bf16_t* Kg, const GAS bf16_t* Vg, const int ldkv, const int qb, const GAS float* kmean,
                                          GAS bf16_t* Og, const int ldo, const GAS bf16_t* Zg) {
    const int lane = tid & 63, wave = __builtin_amdgcn_readfirstlane(tid >> 6), q32 = lane & 31, hi = lane >> 5;
    const int qrow = wave * 32 + q32;
    bf16x8 qf[8];
    { const GAS bf16_t* qp = Qg + (size_t)qrow * ldq + 8 * hi;
#pragma unroll
      for (int ks = 0; ks < 8; ++ks) qf[ks] = *(const GAS bf16x8*)(qp + 16 * ks); }
    const int drow = wave * 8 + (lane >> 4), dpc = lane & 15;
    const int ksrc0 = (dpc ^ (drow & 15)) * 8, ksrc1 = (dpc ^ ((drow + 4) & 15)) * 8;
    const int vsrc0 = ((((dpc >> 2) ^ (drow & 3)) << 2) | (dpc & 3)) * 8, vsrc1 = ((((dpc >> 2) ^ ((drow + 4) & 3)) << 2) | (dpc & 3)) * 8;
    const int ntiles = MODE == 1 ? 4 * (qb + 1) : 4;
#define ATT_KROW(tt) (MODE == 1 ? ((((tt) < 4) ? qb : ((tt) >> 2) - 1) * 256 + 64 * ((tt) & 3)) : 64 * (tt))
#define ATT_DMA(tt, buf) do { const size_t r0 = (size_t)(ATT_KROW(tt) + drow) * ldkv; LAS unsigned char* kd = lds + KOFF + (buf) * 16384 + wave * 2048; LAS unsigned char* vd = lds + VOFF + (buf) * 16384 + wave * 2048; \
        __builtin_amdgcn_global_load_lds((const GAS unsigned*)(Kg + r0 + ksrc0), (LAS unsigned*)kd, 16, 0, 0); __builtin_amdgcn_global_load_lds((const GAS unsigned*)(Kg + r0 + (size_t)4 * ldkv + ksrc1), (LAS unsigned*)(kd + 1024), 16, 0, 0); \
        __builtin_amdgcn_global_load_lds((const GAS unsigned*)(Vg + r0 + vsrc0), (LAS unsigned*)vd, 16, 0, 0); __builtin_amdgcn_global_load_lds((const GAS unsigned*)(Vg + r0 + (size_t)4 * ldkv + vsrc1), (LAS unsigned*)(vd + 1024), 16, 0, 0); } while (0)
    ATT_DMA(0, 0);
    unsigned selmask = 0u;
    if (MODE == 1) {
        LAS float* km = (LAS float*)(lds + SCR_OFF);
        for (int i = tid; i < 8 * 128; i += NTHR) km[i] = kmean[(i >> 7) * DM + (i & 127)] * (1.f / 256.f);
        __syncthreads();
        float g[8];
#pragma unroll
        for (int n = 0; n < 8; ++n) g[n] = 0.f;
#pragma unroll
        for (int ks = 0; ks < 8; ++ks) {
            float qv[8];
#pragma unroll
            for (int j = 0; j < 8; ++j) qv[j] = bf2f((bf16_t)qf[ks][j]);
#pragma unroll
            for (int n = 0; n < 8; ++n) {
                const f32x4 k0 = *(const LAS f32x4*)(km + n * 128 + 16 * ks + 8 * hi), k1 = *(const LAS f32x4*)(km + n * 128 + 16 * ks + 8 * hi + 4);
                g[n] += (qv[0] * k0[0] + qv[1] * k0[1]) + (qv[2] * k0[2] + qv[3] * k0[3]) + (qv[4] * k1[0] + qv[5] * k1[1]) + (qv[6] * k1[2] + qv[7] * k1[3]);
            }
        }
#pragma unroll
        for (int n = 0; n < 8; ++n) { g[n] = xhalf_sum(g[n]); if (n >= qb) g[n] = -INFINITY; }
        const int nsel = qb < 3 ? qb : 3;
#pragma unroll
        for (int i = 0; i < 3; ++i) {
            int best = 0; float bv = -INFINITY;
#pragma unroll
            for (int n = 0; n < 8; ++n) if (g[n] > bv) { bv = g[n]; best = n; }
            if (i < nsel) selmask |= 1u << best;
#pragma unroll
            for (int n = 0; n < 8; ++n) if (n == best) g[n] = -INFINITY;
        }
    }
    int kaddr[8];
#pragma unroll
    for (int ks = 0; ks < 8; ++ks) kaddr[ks] = q32 * 256 + (((2 * ks + hi) ^ (q32 & 15)) << 4);
    int vaddr[4];
    { const int x = (lane >> 2) & 3, rowl = 4 * hi + ((lane >> 2) & 3);
#pragma unroll
      for (int dvt = 0; dvt < 4; ++dvt) vaddr[dvt] = rowl * 256 + ((dvt ^ x) << 6) + 32 * ((lane >> 4) & 1) + 8 * (lane & 3); }
    f32x16 o[4];
#pragma unroll
    for (int d = 0; d < 4; ++d)
#pragma unroll
        for (int r = 0; r < 16; ++r) o[d][r] = 0.f;
    float m_run = -1e30f, l_run = 0.f;
    asm volatile("s_waitcnt vmcnt(0)" ::: "memory");
    __syncthreads();
    for (int tt = 0; tt < ntiles; ++tt) {
        const int buf = tt & 1;
        if (tt + 1 < ntiles) ATT_DMA(tt + 1, buf ^ 1);
        bool active = true;
        if (MODE == 1) { if (tt < 4) active = (64 * tt <= wave * 32 + 31); }
        if (active && KN >= 2) {
            const LAS unsigned char* kb = lds + KOFF + buf * 16384; const LAS unsigned char* vb = lds + VOFF + buf * 16384;
            f32x16 p0, p1;
#pragma unroll
            for (int r = 0; r < 16; ++r) { p0[r] = 0.f; p1[r] = 0.f; }
            { bf16x8 ka[8], kc[8];
#pragma unroll
              for (int ks = 0; ks < 8; ++ks) { ka[ks] = *(const LAS bf16x8*)(kb + kaddr[ks]); kc[ks] = *(const LAS bf16x8*)(kb + 8192 + kaddr[ks]); }
#pragma unroll
              for (int ks = 0; ks < 8; ++ks) { p0 = mfma32(ka[ks], qf[ks], p0); p1 = mfma32(kc[ks], qf[ks], p1); } }
            if (KN >= 3) {
            float moff = 0.f;
            if (MODE == 1) {
                if (tt < 4) {
                    const int kb0 = 64 * tt + 4 * hi;
#pragma unroll
                    for (int r = 0; r < 16; ++r) { const int kk = kb0 + (r & 3) + 8 * (r >> 2); if (kk > qrow) p0[r] = -INFINITY; if (kk + 32 > qrow) p1[r] = -INFINITY; }
                } else if (!((selmask >> ((tt >> 2) - 1)) & 1u)) moff = -INFINITY;
            }
            float mt, mb;
            { float a = max3f(p0[0], p0[1], p1[0]), b = max3f(p0[2], p0[3], p1[1]); a = max3f(a, p1[2], p1[3]);
#pragma unroll
              for (int r = 4; r < 16; r += 4) { a = max3f(a, p0[r], p0[r + 1]); b = max3f(b, p0[r + 2], p0[r + 3]); a = max3f(a, p1[r], p1[r + 1]); b = max3f(b, p1[r + 2], p1[r + 3]); }
              mt = max2f(a, b) + moff; mb = 0.f; (void)mb; }
            mt = xhalf_max(mt) * sc;
            if (__any(mt > m_run + 8.f)) {
                const float mn = fmaxf(m_run, mt); const float alpha = __builtin_amdgcn_exp2f(m_run - mn);
#pragma unroll
                for (int d = 0; d < 4; ++d)
#pragma unroll
                    for (int r = 0; r < 16; ++r) o[d][r] *= alpha;
                l_run *= alpha; m_run = mn;
            }
            float ls = 0.f;
            const float nm = moff - m_run;
#pragma unroll
            for (int r = 0; r < 16; ++r) { p0[r] = __builtin_amdgcn_exp2f(fmaf(p0[r], sc, nm)); p1[r] = __builtin_amdgcn_exp2f(fmaf(p1[r], sc, nm)); ls += p0[r] + p1[r]; }
            l_run += ls;
            if (KN >= 4) {
            bf16x8 pa[2][2];
#pragma unroll
            for (int s2 = 0; s2 < 2; ++s2) {
                u32x4 w0, w1;
                w0.x = pk2(p0[8 * s2 + 0], p0[8 * s2 + 1]); w0.y = pk2(p0[8 * s2 + 2], p0[8 * s2 + 3]); w0.z = pk2(p0[8 * s2 + 4], p0[8 * s2 + 5]); w0.w = pk2(p0[8 * s2 + 6], p0[8 * s2 + 7]);
                w1.x = pk2(p1[8 * s2 + 0], p1[8 * s2 + 1]); w1.y = pk2(p1[8 * s2 + 2], p1[8 * s2 + 3]); w1.z = pk2(p1[8 * s2 + 4], p1[8 * s2 + 5]); w1.w = pk2(p1[8 * s2 + 6], p1[8 * s2 + 7]);
                pa[0][s2] = __builtin_bit_cast(bf16x8, w0); pa[1][s2] = __builtin_bit_cast(bf16x8, w1);
            }
#define ATT_VLOAD(dst, g) do { _Pragma("unroll") for (int dvt = 0; dvt < 4; ++dvt) { const LAS unsigned char* vp = vb + vaddr[dvt] + (((g) >> 1) * 32 + ((g) & 1) * 16) * 256; dst[dvt] = cat2(vtr(vp), vtr(vp + 8 * 256)); } } while (0)
#define ATT_PV(src, g) do { _Pragma("unroll") for (int dvt = 0; dvt < 4; ++dvt) o[dvt] = mfma32(src[dvt], pa[(g) >> 1][(g) & 1], o[dvt]); } while (0)
            { bf16x8 vA[4], vB[4];
              ATT_VLOAD(vA, 0); ATT_VLOAD(vB, 1); ATT_PV(vA, 0); ATT_VLOAD(vA, 2); ATT_PV(vB, 1); ATT_VLOAD(vB, 3); ATT_PV(vA, 2); ATT_PV(vB, 3); }
#undef ATT_VLOAD
#undef ATT_PV
            } else { asm volatile("" :: "v"(p0), "v"(p1)); }
            } else { asm volatile("" :: "v"(p0), "v"(p1)); }
        }
        asm volatile("s_waitcnt vmcnt(0)" ::: "memory");
        __syncthreads();
    }
    const float inv = 1.f / xhalf_sum(l_run);
    GAS bf16_t* orow = Og + (size_t)qrow * ldo + 4 * hi;
    const GAS bf16_t* zrow = (Zg ? Zg : (const GAS bf16_t*)Og) + (size_t)qrow * ldo + 4 * hi;
    u32x2 zz[16];
#pragma unroll
    for (int i = 0; i < 16; ++i) zz[i] = *(const GAS u32x2*)(zrow + (i >> 2) * 32 + 8 * (i & 3));
    const bool hz = Zg != nullptr;
#pragma unroll
    for (int dvt = 0; dvt < 4; ++dvt)
#pragma unroll
        for (int g4 = 0; g4 < 4; ++g4) {
            float v0 = o[dvt][4 * g4 + 0] * inv, v1 = o[dvt][4 * g4 + 1] * inv, v2 = o[dvt][4 * g4 + 2] * inv, v3 = o[dvt][4 * g4 + 3] * inv;
            const int col = dvt * 32 + 8 * g4;
            const u32x2 z = zz[dvt * 4 + g4];
            v0 *= hz ? __uint_as_float(z.x << 16) : 1.f; v1 *= hz ? __uint_as_float(z.x & 0xffff0000u) : 1.f; v2 *= hz ? __uint_as_float(z.y << 16) : 1.f; v3 *= hz ? __uint_as_float(z.y & 0xffff0000u) : 1.f;
            u32x2 w; w.x = pk2(v0, v1); w.y = pk2(v2, v3);
            *(GAS u32x2*)(orow + col) = w;
        }
#undef ATT_KROW
#undef ATT_DMA
}
}

namespace lin {
using att::f32x16; using att::mfma32; using att::vtr; using att::xhalf_sum;
constexpr int XR = 0  , QR = 32768  , VT = 65536  , QT = 98304, KT = 114688, TOT = RING_BYTES + 2048  , EREF = TOT + 4096, ELAST = EREF + 512, SSQ = ELAST + 512, SSQ2 = SSQ + 1024, DSTG = RING_BYTES + 12288  ;
__device__ __forceinline__ int swz(int row) { return ((row & 3) << 2) | ((row >> 2) & 3); }
__device__ __forceinline__ int off16(int row, int ch) { return row * 256 + ((ch ^ swz(row)) << 4); }
__device__ __forceinline__ int offb(int row, int colbyte) { return off16(row, colbyte >> 4) + (colbyte & 15); }
__device__ __forceinline__ bf16x8 pack8(const f32x16& p, int s2) {
    u32x4 w; w.x = pk2(p[8 * s2 + 0], p[8 * s2 + 1]); w.y = pk2(p[8 * s2 + 2], p[8 * s2 + 3]); w.z = pk2(p[8 * s2 + 4], p[8 * s2 + 5]); w.w = pk2(p[8 * s2 + 6], p[8 * s2 + 7]);
    return __builtin_bit_cast(bf16x8, w);
}
__device__ __forceinline__ bf16x8 permfrag(const LAS unsigned char* tile, int R, int ks, int pb) {
    const u32x2 lo = *(const LAS u32x2*)(tile + R * 256 + (pb ^ ((2 * ks) << 4))), hh = *(const LAS u32x2*)(tile + R * 256 + (pb ^ ((2 * ks + 1) << 4)));
    u32x4 w; w.x = lo.x; w.y = lo.y; w.z = hh.x; w.w = hh.y; return __builtin_bit_cast(bf16x8, w);
}
__device__ __forceinline__ bf16x8 trfrag1(const LAS unsigned char* tile, int R, int C, int tb1) {
    return att::cat2(vtr(tile + R * 256 + (tb1 ^ (C << 6))), vtr(tile + (R + 8) * 256 + (tb1 ^ ((C << 6) | 32))));
}
__device__ __forceinline__ bf16x8 trfrag2(const LAS unsigned char* tile, int R, int C, int tb2) {
    return att::cat2(vtr(tile + R * 256 + (tb2 ^ (C << 6))), vtr(tile + (R + 4) * 256 + (tb2 ^ ((C << 6) | 16))));
}

template <int KIND  , bool PASS_B, int KN = 4>
__device__ __forceinline__ void linatt_item(LAS unsigned char* lds, const int tid, const GAS bf16_t* Qg, const GAS bf16_t* Xg, const GAS bf16_t* Vg,
                                            const GAS float* aux, const float gam, const float gsc, GAS float* Ubh, GAS float* Dbh, const int sc, GAS bf16_t* Yg, const GAS bf16_t* Zg, const GAS float* gain, const GAS float* bias) {
    const int lane = tid & 63, wave = __builtin_amdgcn_readfirstlane(tid >> 6), q32 = lane & 31, hi = lane >> 5, ct = wave & 1, dt = wave >> 1;
    const int pb_k = q32 * 256 + (swz(q32) << 4) + 8 * hi;
    const int x_ = (lane >> 2) & 3, gl_ = 2 * ((lane >> 4) & 1) + ((lane & 3) >> 1);
    const int tb1_k = (4 * hi + x_) * 256 + (x_ << 6) + ((gl_ ^ hi) << 4) + 8 * (lane & 1);
    const int tb2_k = (8 * hi + x_) * 256 + (x_ << 6) + ((gl_ ^ (2 * hi)) << 4) + 8 * (lane & 1);
    f32x16 S[4];
#pragma unroll
    for (int t = 0; t < 4; ++t)
#pragma unroll
        for (int r = 0; r < 16; ++r) S[t][r] = 0.f;
    float dprod0 = 1.f, dprod1 = 1.f;
#define LIN_DMA(chk, buf, ln) do { const int drow = wave * 8 + ((ln) >> 4), dch = (ln) & 15; const int vsr0 = (dch ^ swz(drow)) * 8, vsr1 = (dch ^ swz(drow + 4)) * 8; \
        const unsigned r0 = (unsigned)((chk) * 64 + drow) * DM; const int ld_ = (buf) * 16384 + wave * 2048; \
        __builtin_amdgcn_global_load_lds((const GAS unsigned*)(Xg + (r0 + dch * 8)), (LAS unsigned*)(lds + XR + ld_), 16, 0, 0); __builtin_amdgcn_global_load_lds((const GAS unsigned*)(Xg + (r0 + 4 * DM + dch * 8)), (LAS unsigned*)(lds + XR + ld_ + 1024), 16, 0, 0); \
        if (PASS_B) { __builtin_amdgcn_global_load_lds((const GAS unsigned*)(Qg + (r0 + dch * 8)), (LAS unsigned*)(lds + QR + ld_), 16, 0, 0); __builtin_amdgcn_global_load_lds((const GAS unsigned*)(Qg + (r0 + 4 * DM + dch * 8)), (LAS unsigned*)(lds + QR + ld_ + 1024), 16, 0, 0); } \
        __builtin_amdgcn_global_load_lds((const GAS unsigned*)(Vg + (r0 + vsr0)), (LAS unsigned*)(lds + VT + ld_), 16, 0, 0); __builtin_amdgcn_global_load_lds((const GAS unsigned*)(Vg + (r0 + 4 * DM + vsr1)), (LAS unsigned*)(lds + VT + ld_ + 1024), 16, 0, 0); } while (0)
    f32x2 lb2 = (f32x2){0.f, 0.f}; if (KIND == 0) lb2 = *(const GAS f32x2*)(aux + 2 * (tid & 63));
    { int l0 = lane; asm volatile("" : "+v"(l0)); LIN_DMA(0, 0, l0); }
    if (PASS_B) {
        u32x2 ua[16], uc[16];
#define LIN_UISSUE(dst, j_) do { const GAS bf16_t* up_ = (const GAS bf16_t*)Ubh + (size_t)(j_) * 16384 + (dt * 4 * 64 + lane) * 16; \
            _Pragma("unroll") for (int t = 0; t < 4; ++t) _Pragma("unroll") for (int g4 = 0; g4 < 4; ++g4) dst[4 * t + g4] = *(const GAS u32x2*)(up_ + t * 1024 + 4 * g4); } while (0)
#define LIN_UCOMB(src, j_) do { _Pragma("unroll") for (int t = 0; t < 4; ++t) _Pragma("unroll") for (int g4 = 0; g4 < 4; ++g4) { \
            f32x4 d4; if (KIND == 0) d4 = *(const LAS f32x4*)(lds + DSTG + ((j_) * 128 + 32 * t + 8 * g4 + 4 * hi) * 4); else d4 = (f32x4){gsc, gsc, gsc, gsc}; \
            const u32x2 ub = src[4 * t + g4]; \
            const f32x4 u4 = (f32x4){__uint_as_float(ub.x << 16), __uint_as_float(ub.x & 0xffff0000u), __uint_as_float(ub.y << 16), __uint_as_float(ub.y & 0xffff0000u)}; \
            _Pragma("unroll") for (int e = 0; e < 4; ++e) S[t][4 * g4 + e] = d4[e] * S[t][4 * g4 + e] + u4[e]; } } while (0)
        if (sc > 0) LIN_UISSUE(ua, 0);
        if (KIND == 0) {
            for (int i = tid; i < sc * 128; i += NTHR) ((LAS float*)(lds + DSTG))[i] = Dbh[i];
            lds_barrier();
        }
        for (int j = 0; j < sc; j += 2) {
            asm volatile("" ::: "memory");
            if (j + 1 < sc) LIN_UISSUE(uc, j + 1);
            asm volatile("" ::: "memory");
            LIN_UCOMB(ua, j);
            if (j + 1 < sc) {
                asm volatile("" ::: "memory");
                if (j + 2 < sc) LIN_UISSUE(ua, j + 2);
                asm volatile("" ::: "memory");
                LIN_UCOMB(uc, j + 1);
            }
        }
#undef LIN_UISSUE
#undef LIN_UCOMB
    }
    asm volatile("s_waitcnt vmcnt(0)" ::: "memory");
    lds_barrier();
#pragma unroll 1
    for (int chk = 0; chk < 4; ++chk) {
        int pb = pb_k, tb1 = tb1_k, tb2 = tb2_k, qm = q32 - 4 * hi;
        int tid_c = tid;
        asm volatile("" : "+v"(pb), "+v"(tb1), "+v"(tb2), "+v"(qm), "+v"(tid_c));
        const int bo = (chk & 1) * 16384;
        if (KIND == 0) {
            const int dkp = tid_c & 63, tg = __builtin_amdgcn_readfirstlane(tid_c >> 6);
            float pl0[8], pl1[8], kk0[8], kk1[8]; float p0 = 1.f, p1 = 1.f;
            const LAS unsigned char* xrp = lds + XR + bo + tg * 2048 + dkp * 4;
#pragma unroll
            for (int i = 0; i < 8; ++i) { const unsigned xw = *(const LAS unsigned*)(xrp + i * 256);
                const float f0 = lb2.x + (1.f - lb2.x) * sigmoidf_(__uint_as_float(xw << 16)), f1 = lb2.y + (1.f - lb2.y) * sigmoidf_(__uint_as_float(xw & 0xffff0000u));
                p0 *= f0; p1 *= f1; pl0[i] = p0; pl1[i] = p1; kk0[i] = 1.f - f0; kk1[i] = 1.f - f1; }
            *(LAS f32x2*)(lds + TOT + (tg * 128 + 2 * dkp) * 4) = (f32x2){p0, p1};
            lds_barrier();
            f32x2 T[8];
#pragma unroll
            for (int g = 0; g < 8; ++g) T[g] = *(const LAS f32x2*)(lds + TOT + (g * 128 + 2 * dkp) * 4);
            float R0 = 1.f, R1 = 1.f;
#pragma unroll
            for (int g = 0; g < 8; ++g) { const bool in = (tg < 4) ? (g >= tg && g < 4) : (g >= 4 && g < tg); if (in) { R0 *= T[g].x; R1 *= T[g].y; } }
            if (tg < 4) { R0 = __builtin_amdgcn_rcpf(R0); R1 = __builtin_amdgcn_rcpf(R1); }
            const int wb = tg * 2048 + ((dkp >> 2) << 4) + (dkp & 3) * 4;
            const LAS unsigned char* qrp = lds + QR + bo + tg * 2048 + dkp * 4;
#pragma unroll
            for (int i = 0; i < 8; ++i) { const float E0 = pl0[i] * R0, E1 = pl1[i] * R1;
                const int o = (wb ^ (swz(8 * tg + i) << 4)) + i * 256;
                *(LAS unsigned*)(lds + KT + o) = pk2(kk0[i] * __builtin_amdgcn_rcpf(E0), kk1[i] * __builtin_amdgcn_rcpf(E1));
                if (PASS_B) { const unsigned qw = *(const LAS unsigned*)(qrp + i * 256); *(LAS unsigned*)(lds + QT + o) = pk2(__uint_as_float(qw << 16) * E0, __uint_as_float(qw & 0xffff0000u) * E1); } }
            if (tg == 0) { const float er0 = (T[0].x * T[1].x) * (T[2].x * T[3].x), er1 = (T[0].y * T[1].y) * (T[2].y * T[3].y), el0 = (T[4].x * T[5].x) * (T[6].x * T[7].x), el1 = (T[4].y * T[5].y) * (T[6].y * T[7].y);
                *(LAS f32x2*)(lds + EREF + dkp * 8) = (f32x2){er0, er1}; *(LAS f32x2*)(lds + ELAST + dkp * 8) = (f32x2){el0, el1}; dprod0 *= er0 * el0; dprod1 *= er1 * el1; }
        } else {
            const int dp = tid_c & 31, tg = tid_c >> 5;
            const GAS float* cst = aux + (size_t)(chk * 64 + 4 * tg) * 128 + dp * 4;
            const float l2g = __log2f(gam);
            const LAS unsigned char* xrp = lds + XR + bo + tg * 1024 + dp * 4; const LAS unsigned char* qrp = lds + QR + bo + tg * 1024 + dp * 4;
            const int wb = tg * 1024 + (dp & 3) * 4;
#pragma unroll
            for (int i = 0; i < 4; ++i) { const int s_ = 4 * tg + i;
                const f32x4 cs = *(const GAS f32x4*)(cst + (size_t)i * 128);
                const float dq = exp2f((float)(s_ - 31) * l2g), dkf = QK_SCALE * exp2f((float)(31 - s_) * l2g);
                const int sw = ((i & 3) << 2) | (tg & 3), olo = wb + i * 256 + (((dp >> 2) ^ sw) << 4), ohi = wb + i * 256 + ((((dp >> 2) + 8) ^ sw) << 4);
                { const unsigned lo = *(const LAS unsigned*)(xrp + i * 256), hh = *(const LAS unsigned*)(xrp + i * 256 + 128);
                  const float a0 = __uint_as_float(lo << 16), a1 = __uint_as_float(lo & 0xffff0000u), b0 = __uint_as_float(hh << 16), b1 = __uint_as_float(hh & 0xffff0000u);
                  *(LAS unsigned*)(lds + KT + olo) = pk2((a0 * cs[0] - b0 * cs[1]) * dkf, (a1 * cs[2] - b1 * cs[3]) * dkf);
                  *(LAS unsigned*)(lds + KT + ohi) = pk2((b0 * cs[0] + a0 * cs[1]) * dkf, (b1 * cs[2] + a1 * cs[3]) * dkf); }
                if (PASS_B) { const unsigned lo = *(const LAS unsigned*)(qrp + i * 256), hh = *(const LAS unsigned*)(qrp + i * 256 + 128);
                  const float a0 = __uint_as_float(lo << 16), a1 = __uint_as_float(lo & 0xffff0000u), b0 = __uint_as_float(hh << 16), b1 = __uint_as_float(hh & 0xffff0000u);
                  *(LAS unsigned*)(lds + QT + olo) = pk2((a0 * cs[0] - b0 * cs[1]) * dq, (a1 * cs[2] - b1 * cs[3]) * dq);
                  *(LAS unsigned*)(lds + QT + ohi) = pk2((b0 * cs[0] + a0 * cs[1]) * dq, (b1 * cs[2] + a1 * cs[3]) * dq); } }
            if (tid_c < 128) { const float e32 = exp2f(32.f * l2g); ((LAS float*)(lds + EREF))[tid_c] = e32; ((LAS float*)(lds + ELAST))[tid_c] = e32; }
        }
        if (chk + 1 < 4) LIN_DMA(chk + 1, (chk + 1) & 1, tid_c & 63);
        lds_barrier();
        u32x2 zpre[4];
        if (PASS_B) { const GAS bf16_t* zrow_ = Zg + (size_t)(chk * 64 + ct * 32 + q32) * DM + dt * 32 + 4 * hi;
#pragma unroll
            for (int g4 = 0; g4 < 4; ++g4) zpre[g4] = *(const GAS u32x2*)(zrow_ + 8 * g4); }
#pragma unroll
        for (int t = 0; t < 4; ++t)
#pragma unroll
            for (int g4 = 0; g4 < 4; ++g4) { const f32x4 er = *(const LAS f32x4*)(lds + EREF + (32 * t + 8 * g4 + 4 * hi) * 4);
#pragma unroll
                for (int e = 0; e < 4; ++e) S[t][4 * g4 + e] *= er[e]; }
        f32x16 oT;
#pragma unroll
        for (int r = 0; r < 16; ++r) oT[r] = 0.f;
        if (PASS_B && KN >= 3) {
            bf16x8 qp[8];
#pragma unroll
            for (int ks = 0; ks < 8; ++ks) qp[ks] = permfrag(lds + QT, ct * 32, ks, pb);
#pragma unroll
            for (int st = 0; st < 2; ++st) {
                if (st <= ct) {
                    f32x16 p;
#pragma unroll
                    for (int r = 0; r < 16; ++r) p[r] = 0.f;
                    bf16x8 kf[8];
#pragma unroll
                    for (int ks = 0; ks < 8; ++ks) kf[ks] = permfrag(lds + KT, st * 32, ks, pb);
#pragma unroll
                    for (int ks = 0; ks < 8; ++ks) p = mfma32(kf[ks], qp[ks], p);
                    if (st == ct) {
#pragma unroll
                        for (int r = 0; r < 16; ++r) { const int sl = (r & 3) + 8 * (r >> 2); if (sl > qm) p[r] = 0.f; }
                    }
#pragma unroll
                    for (int s2 = 0; s2 < 2; ++s2) oT = mfma32(trfrag1(lds + VT + bo, st * 32 + 16 * s2, dt, tb1), pack8(p, s2), oT);
                }
            }
#pragma unroll
            for (int t = 0; t < 4; ++t)
#pragma unroll
                for (int s2 = 0; s2 < 2; ++s2) oT = mfma32(pack8(S[t], s2), qp[2 * t + s2], oT);
        }
        if (KN >= 2)
#pragma unroll
        for (int ks = 0; ks < 4; ++ks) {
            const bf16x8 vb = trfrag2(lds + VT + bo, 16 * ks, dt, tb2);
#pragma unroll
            for (int t = 0; t < 4; ++t) S[t] = mfma32(trfrag2(lds + KT, 16 * ks, t, tb2), vb, S[t]);
        }
#pragma unroll
        for (int t = 0; t < 4; ++t)
#pragma unroll
            for (int g4 = 0; g4 < 4; ++g4) { const f32x4 el = *(const LAS f32x4*)(lds + ELAST + (32 * t + 8 * g4 + 4 * hi) * 4);
#pragma unroll
                for (int e = 0; e < 4; ++e) S[t][4 * g4 + e] *= el[e]; }
        if (PASS_B && KN < 4) { asm volatile("" :: "v"(oT)); asm volatile("s_waitcnt vmcnt(0)" ::: "memory"); lds_barrier(); }
        else if (PASS_B) {
            f32x4 gnv[4], bsv[4];
#pragma unroll
            for (int g4 = 0; g4 < 4; ++g4) { gnv[g4] = *(const GAS f32x4*)(gain + dt * 32 + 8 * g4 + 4 * hi);
                bsv[g4] = (f32x4){0.f, 0.f, 0.f, 0.f}; if (KIND == 1) bsv[g4] = *(const GAS f32x4*)(bias + dt * 32 + 8 * g4 + 4 * hi); }
            float s1 = 0.f, s2 = 0.f;
#pragma unroll
            for (int r = 0; r < 16; ++r) { s1 += oT[r]; s2 += oT[r] * oT[r]; }
            s2 = xhalf_sum(s2); if (KIND == 1) s1 = xhalf_sum(s1);
            if (hi == 0) { ((LAS float*)(lds + SSQ))[(ct * 4 + dt) * 32 + q32] = s2; if (KIND == 1) ((LAS float*)(lds + SSQ2))[(ct * 4 + dt) * 32 + q32] = s1; }
            asm volatile("s_waitcnt vmcnt(0)" ::: "memory");
            lds_barrier();
            const LAS float* sq = (const LAS float*)(lds + SSQ) + ct * 128 + q32;
            const float tot2 = (sq[0] + sq[32]) + (sq[64] + sq[96]);
            float mu = 0.f, rstd;
            if (KIND == 0) rstd = rsqrtf(tot2 * (1.f / 128.f) + EPS);
            else { const LAS float* sm = (const LAS float*)(lds + SSQ2) + ct * 128 + q32; mu = ((sm[0] + sm[32]) + (sm[64] + sm[96])) * (1.f / 128.f);
                   const float var = tot2 * (1.f / 128.f) - mu * mu; rstd = rsqrtf(fmaxf(var, 0.f) + EPS); }
            GAS bf16_t* yrow = Yg + (size_t)(chk * 64 + ct * 32 + q32) * DM + dt * 32 + 4 * hi;
#pragma unroll
            for (int g4 = 0; g4 < 4; ++g4) {
                const f32x4 gn = gnv[g4], bs = bsv[g4];
                const u32x2 z = zpre[g4];
                const float v0 = ((oT[4 * g4 + 0] - mu) * rstd * gn[0] + bs[0]) * __uint_as_float(z.x << 16), v1 = ((oT[4 * g4 + 1] - mu) * rstd * gn[1] + bs[1]) * __uint_as_float(z.x & 0xffff0000u);
                const float v2 = ((oT[4 * g4 + 2] - mu) * rstd * gn[2] + bs[2]) * __uint_as_float(z.y << 16), v3 = ((oT[4 * g4 + 3] - mu) * rstd * gn[3] + bs[3]) * __uint_as_float(z.y & 0xffff0000u);
                u32x2 w; w.x = pk2(v0, v1); w.y = pk2(v2, v3); *(GAS u32x2*)(yrow + 8 * g4) = w;
            }
        } else {
            asm volatile("s_waitcnt vmcnt(0)" ::: "memory"); lds_barrier();
        }
    }
    if (!PASS_B) {
        if (ct == 0) {
#pragma unroll
            for (int t = 0; t < 4; ++t)
#pragma unroll
                for (int g4 = 0; g4 < 4; ++g4) { f32x4 u4; u4[0] = S[t][4 * g4]; u4[1] = S[t][4 * g4 + 1]; u4[2] = S[t][4 * g4 + 2]; u4[3] = S[t][4 * g4 + 3];
                    u32x2 ub; ub.x = pk2(u4[0], u4[1]); ub.y = pk2(u4[2], u4[3]); *(GAS u32x2*)((GAS bf16_t*)Ubh + (size_t)sc * 16384 + ((dt * 4 + t) * 64 + lane) * 16 + 4 * g4) = ub; }
        }
        if (KIND == 0 && wave == 0) *(GAS f32x2*)(Dbh + sc * 128 + 2 * (tid & 63)) = (f32x2){dprod0, dprod1};
    }
#undef LIN_DMA
}

template <int KIND>
__device__ __forceinline__ void passA_item(LAS unsigned char* lds, const int tid, const GAS bf16_t* Xg, const GAS bf16_t* Vg, const GAS float* aux, const float gam,
                                           GAS float* Ubh, GAS float* Dbh, const int sc) {
    constexpr int XT_ = 0, VT_ = 65536, TOT_ = RING_BYTES + 2048;
    const int lane = tid & 63, wave = __builtin_amdgcn_readfirstlane(tid >> 6), hi = lane >> 5, dt = wave & 3, th = wave >> 2;
    { u32x4 xv[8], vv[8];
#pragma unroll
      for (int i = 0; i < 8; ++i) { const int cid = tid + 512 * i, row = cid >> 4, ch = cid & 15; const size_t go = (size_t)row * DM + ch * 8; xv[i] = *(const GAS u32x4*)(Xg + go); vv[i] = *(const GAS u32x4*)(Vg + go); }
#pragma unroll
      for (int i = 0; i < 8; ++i) { const int cid = tid + 512 * i, row = cid >> 4, ch = cid & 15; *(LAS u32x4*)(lds + XT_ + off16(row, ch)) = xv[i]; *(LAS u32x4*)(lds + VT_ + off16(row, ch)) = vv[i]; } }
    __syncthreads();
    if (KIND == 0) {
        const int dkp = tid & 63, tg = wave; const f32x2 lb2 = *(const GAS f32x2*)(aux + 2 * dkp);
        float r0 = 1.f, r1 = 1.f;
#pragma unroll 4
        for (int i = 31; i >= 0; --i) { const int s_ = 32 * tg + i; LAS unsigned* p = (LAS unsigned*)(lds + XT_ + s_ * 256 + (((dkp >> 2) ^ swz(s_)) << 4) + (dkp & 3) * 4);
            const unsigned xw = *p;
            const float f0 = lb2.x + (1.f - lb2.x) * sigmoidf_(__uint_as_float(xw << 16)), f1 = lb2.y + (1.f - lb2.y) * sigmoidf_(__uint_as_float(xw & 0xffff0000u));
            *p = pk2((1.f - f0) * r0, (1.f - f1) * r1); r0 *= f0; r1 *= f1; }
        *(LAS f32x2*)(lds + TOT_ + (tg * 128 + 2 * dkp) * 4) = (f32x2){r0, r1};
    } else {
        const int dp = tid & 31, tg = tid >> 5; const float l2g = __log2f(gam);
        const GAS float* cst = aux + (size_t)(16 * tg) * 128 + dp * 4;
#pragma unroll 4
        for (int i = 0; i < 16; ++i) { const int s_ = 16 * tg + i; const f32x4 cs = *(const GAS f32x4*)(cst + (size_t)i * 128);
            const float dkf = QK_SCALE * exp2f((float)(255 - s_) * l2g);
            LAS unsigned* plo = (LAS unsigned*)(lds + XT_ + s_ * 256 + (((dp >> 2) ^ swz(s_)) << 4) + (dp & 3) * 4); LAS unsigned* phi = (LAS unsigned*)(lds + XT_ + s_ * 256 + ((((dp >> 2) + 8) ^ swz(s_)) << 4) + (dp & 3) * 4);
            const unsigned lo = *plo, hh = *phi;
            const float a0 = __uint_as_float(lo << 16), a1 = __uint_as_float(lo & 0xffff0000u), b0 = __uint_as_float(hh << 16), b1 = __uint_as_float(hh & 0xffff0000u);
            *plo = pk2((a0 * cs[0] - b0 * cs[1]) * dkf, (a1 * cs[2] - b1 * cs[3]) * dkf); *phi = pk2((b0 * cs[0] + a0 * cs[1]) * dkf, (b1 * cs[2] + a1 * cs[3]) * dkf); }
    }
    __syncthreads();
    const int x_ = (lane >> 2) & 3, gl_ = 2 * ((lane >> 4) & 1) + ((lane & 3) >> 1);
    const int tb2 = (8 * hi + x_) * 256 + (x_ << 6) + ((gl_ ^ (2 * hi)) << 4) + 8 * (lane & 1);
    f32x16 acc[2];
#pragma unroll
    for (int t2 = 0; t2 < 2; ++t2)
#pragma unroll
        for (int r = 0; r < 16; ++r) acc[t2][r] = 0.f;
#pragma unroll
    for (int ks = 0; ks < 16; ++ks) {
        if (KIND == 0 && (ks & 1) == 0 && ks > 0) {
#pragma unroll
            for (int t2 = 0; t2 < 2; ++t2)
#pragma unroll
                for (int g4 = 0; g4 < 4; ++g4) { const f32x4 tg4 = *(const LAS f32x4*)(lds + TOT_ + ((ks >> 1) * 128 + 32 * (2 * th + t2) + 8 * g4 + 4 * hi) * 4);
#pragma unroll
                    for (int e = 0; e < 4; ++e) acc[t2][4 * g4 + e] *= tg4[e]; }
        }
        const bf16x8 vb = trfrag2(lds + VT_, 16 * ks, dt, tb2);
#pragma unroll
        for (int t2 = 0; t2 < 2; ++t2) acc[t2] = mfma32(trfrag2(lds + XT_, 16 * ks, 2 * th + t2, tb2), vb, acc[t2]);
    }
#pragma unroll
    for (int t2 = 0; t2 < 2; ++t2)
#pragma unroll
        for (int g4 = 0; g4 < 4; ++g4) { f32x4 u4; u4[0] = acc[t2][4 * g4]; u4[1] = acc[t2][4 * g4 + 1]; u4[2] = acc[t2][4 * g4 + 2]; u4[3] = acc[t2][4 * g4 + 3];
            u32x2 ub; ub.x = pk2(u4[0], u4[1]); ub.y = pk2(u4[2], u4[3]); *(GAS u32x2*)((GAS bf16_t*)Ubh + (size_t)sc * 16384 + ((dt * 4 + 2 * th + t2) * 64 + lane) * 16 + 4 * g4) = ub; }
    if (KIND == 0 && tid < 128) { const LAS float* tot = (const LAS float*)(lds + TOT_) + tid; float d = 1.f;
#pragma unroll
        for (int g = 0; g < 8; ++g) d *= tot[g * 128];
        Dbh[sc * 128 + tid] = d; }
}
}


namespace rgc {
using att::f32x16; using att::mfma32;
constexpr int TB = 128, NBLK = SEQ / TB;
constexpr int CXR = 0  , XF = 33792  , PRE = 66560  , XFF = 100352  ,
              GRP = 117248  , CAR = 121344  ;
__device__ __forceinline__ void rg_chain(LAS unsigned char* lds, const int tid, const int bid, const int G, const GAS bf16_t* H0, GAS bf16_t* Y, const GAS bf16_t* WRG,
                                         const GAS float* cwg, const GAS float* cbg, const GAS float* bag, const GAS float* bxg, const GAS float* spg) {
    const int lane = tid & 63, wave = __builtin_amdgcn_readfirstlane(tid >> 6), q32 = lane & 31, hi = lane >> 5, gate = wave & 1, tt = wave >> 1;
    for (int cid = bid; cid < 256; cid += G) {
        const int xs = cid & 7, sl = cid >> 3; const int grp = (G % 8 == 0) ? xs * 8 + (sl >> 2) : (cid >> 2), jt = (G % 8 == 0) ? (sl & 3) : (cid & 3), b = grp >> 3, hb = grp & 7;
        const GAS bf16_t* cx0 = H0 + (size_t)b * SEQ * DM + hb * 128; GAS bf16_t* y0 = Y + (size_t)b * SEQ * DM + hb * 128 + jt * 32;
        bf16x8 wf[8];
        { const GAS bf16_t* wp = WRG + (size_t)gate * 128 * 1024 + hb * 128 + (size_t)(jt * 32 + q32) * 1024 + 8 * hi;
#pragma unroll
          for (int ks = 0; ks < 8; ++ks) wf[ks] = *(const GAS bf16x8*)(wp + 16 * ks); }
        const int cp = tid & 63, t8 = __builtin_amdgcn_readfirstlane(tid >> 6), chc = hb * 128 + 2 * cp;
        const f32x2 w0 = *(const GAS f32x2*)(cwg + chc), w1 = *(const GAS f32x2*)(cwg + DM + chc), w2 = *(const GAS f32x2*)(cwg + 2 * DM + chc), w3 = *(const GAS f32x2*)(cwg + 3 * DM + chc), bb = *(const GAS f32x2*)(cbg + chc);
        const int j = tid & 31, tg = tid >> 5, chj = hb * 128 + jt * 32 + j;
        const float b_a = bag[chj], b_x = bxg[chj], s_p = spg[chj];
        if (tid < 64) ((LAS float*)(lds + CAR))[tid] = 0.f;
        u32x4 pv[4], phv;
#define RGC_ISSUE(blk) do { const GAS bf16_t* cxg = cx0 + (size_t)((blk) * TB) * DM; _Pragma("unroll") for (int i = 0; i < 4; ++i) { const int cidx = tid + 512 * i; pv[i] = *(const GAS u32x4*)(cxg + (size_t)(cidx >> 4) * DM + (cidx & 15) * 8); } \
            phv = (u32x4){0u, 0u, 0u, 0u}; if (tid < 48 && (blk) != 0) phv = *(const GAS u32x4*)(cxg - (size_t)(3 - (tid >> 4)) * DM + (tid & 15) * 8); } while (0)
#define RG_S1 do { _Pragma("unroll") for (int i = 0; i < 4; ++i) { const int cidx = tid + 512 * i; *(LAS u32x4*)(lds + CXR + ((cidx >> 4) + 3) * 256 + (cidx & 15) * 16) = pv[i]; } \
            if (tid < 48) *(LAS u32x4*)(lds + CXR + (tid >> 4) * 256 + (tid & 15) * 16) = phv; } while (0)
        RGC_ISSUE(0);
        RG_S1;
        if (1 < NBLK) RGC_ISSUE(1);
#pragma unroll 1
        for (int blk = 0; blk < NBLK; ++blk) {
            lds_barrier();
            { const LAS unsigned char* rp = lds + CXR + (16 * t8) * 256 + cp * 4;
              const unsigned r0 = *(const LAS unsigned*)(rp), r1 = *(const LAS unsigned*)(rp + 256), r2 = *(const LAS unsigned*)(rp + 512);
              float xa0 = __uint_as_float(r0 << 16), xb0 = __uint_as_float(r0 & 0xffff0000u), xa1 = __uint_as_float(r1 << 16), xb1 = __uint_as_float(r1 & 0xffff0000u), xa2 = __uint_as_float(r2 << 16), xb2 = __uint_as_float(r2 & 0xffff0000u);
              const int wb = t8 * 4096 + ((cp >> 2) << 4) + (cp & 3) * 4; const bool mine = (cp >> 4) == jt;
              LAS float* xfp = (LAS float*)(lds + XFF) + ((2 * cp) & 31) * 132 + 16 * t8;
#pragma unroll
              for (int i4 = 0; i4 < 4; ++i4) { f32x4 fa, fb;
#pragma unroll
                  for (int ii = 0; ii < 4; ++ii) { const int i = 4 * i4 + ii; const unsigned r3 = *(const LAS unsigned*)(rp + (i + 3) * 256);
                      const float xa3 = __uint_as_float(r3 << 16), xb3 = __uint_as_float(r3 & 0xffff0000u);
                      const float xfa = bb.x + w0.x * xa0 + w1.x * xa1 + w2.x * xa2 + w3.x * xa3, xfb = bb.y + w0.y * xb0 + w1.y * xb1 + w2.y * xb2 + w3.y * xb3;
                      xa0 = xa1; xa1 = xa2; xa2 = xa3; xb0 = xb1; xb1 = xb2; xb2 = xb3;
                      *(LAS unsigned*)(lds + XF + ((wb ^ (lin::swz(i) << 4)) + i * 256)) = pk2(xfa, xfb);
                      fa[ii] = xfa; fb[ii] = xfb; }
                  if (mine) { *(LAS f32x4*)(xfp + 4 * i4) = fa; *(LAS f32x4*)(xfp + 132 + 4 * i4) = fb; } } }
            lds_barrier();
            { f32x16 acc;
#pragma unroll
              for (int r = 0; r < 16; ++r) acc[r] = 0.f;
              const int xb = (tt * 32 + q32) * 256 + (lin::swz(q32) << 4);
#pragma unroll
              for (int ks = 0; ks < 8; ++ks) acc = mfma32(wf[ks], *(const LAS bf16x8*)(lds + XF + (xb ^ ((2 * ks + hi) << 4))), acc);
              LAS float* pp = (LAS float*)(lds + PRE) + gate * 32 * 132 + tt * 32 + q32;
#pragma unroll
              for (int r = 0; r < 16; ++r) pp[((r & 3) + 8 * (r >> 2) + 4 * hi) * 132] = acc[r]; }
            lds_barrier();
            float av[8], uv[8]; float Ag = 1.f, Hg = 0.f;
            const size_t yo = (size_t)(blk * TB + 8 * tg) * DM + j;
            unsigned short zv[8];
#pragma unroll
            for (int i = 0; i < 8; ++i) zv[i] = y0[yo + (size_t)i * DM];
            { const LAS float* prp = (const LAS float*)(lds + PRE) + j * 132 + 8 * tg; const LAS float* pxp = (const LAS float*)(lds + XFF) + j * 132 + 8 * tg;
              const f32x4 pa0 = *(const LAS f32x4*)prp, pa1 = *(const LAS f32x4*)(prp + 4), pg0 = *(const LAS f32x4*)(prp + 32 * 132), pg1 = *(const LAS f32x4*)(prp + 32 * 132 + 4);
              const float pr[8] = {pa0[0], pa0[1], pa0[2], pa0[3], pa1[0], pa1[1], pa1[2], pa1[3]}, pg[8] = {pg0[0], pg0[1], pg0[2], pg0[3], pg1[0], pg1[1], pg1[2], pg1[3]};
              const f32x4 px0 = *(const LAS f32x4*)pxp, px1 = *(const LAS f32x4*)(pxp + 4); const float px[8] = {px0[0], px0[1], px0[2], px0[3], px1[0], px1[1], px1[2], px1[3]};
#pragma unroll
              for (int i = 0; i < 8; ++i) {
                  const float rgate = sigmoidf_(pr[i] + b_a), igate = sigmoidf_(pg[i] + b_x);
                  const float la = -8.f * rgate * s_p, e2 = 2.f * la; const float a = __expf(la);
                  const float om = (e2 > -0.01f) ? -(e2 + 0.5f * e2 * e2 + (1.f / 6.f) * e2 * e2 * e2) : 1.f - a * a;
                  const float u = __builtin_amdgcn_sqrtf(om) * igate * px[i];
                  av[i] = a; uv[i] = u; Ag *= a; Hg = a * Hg + u; } }
            *(LAS f32x2*)(lds + GRP + (tg * 32 + j) * 8) = (f32x2){Ag, Hg};
            lds_barrier();
            float h = ((const LAS float*)(lds + CAR))[(blk & 1) * 32 + j];
            {
                f32x2 ah[15];
#pragma unroll
                for (int g = 0; g < 15; ++g) ah[g] = *(const LAS f32x2*)(lds + GRP + (g * 32 + j) * 8);
#pragma unroll
                for (int g = 0; g < 15; ++g) h = (g < tg) ? ah[g].x * h + ah[g].y : h;
            }
            bf16_t yv[8];
#pragma unroll
            for (int i = 0; i < 8; ++i) { h = av[i] * h + uv[i]; yv[i] = f2bf(h * bf2f(zv[i])); }
            if (tg == 15) ((LAS float*)(lds + CAR))[((blk + 1) & 1) * 32 + j] = h;
            if (blk + 1 < NBLK) { RG_S1; if (blk + 2 < NBLK) RGC_ISSUE(blk + 2); }
#pragma unroll
            for (int i = 0; i < 8; ++i) y0[yo + (size_t)i * DM] = yv[i];
        }
#undef RG_S1
        __syncthreads();
#undef RGC_ISSUE
    }
}
}

struct Ctx { LAS unsigned char* lds; LAS u64* ptab; LAS pg8::GD* gd; int tid, lane, wave, bid, G, gw, NGW; };
__device__ __forceinline__ Ctx make_ctx(LAS unsigned char* lds_k, int wave_s) {
    Ctx c; int tid;
    asm volatile("v_mbcnt_lo_u32_b32 %0, -1, 0\n\tv_mbcnt_hi_u32_b32 %0, -1, %0\n\tv_lshl_add_u32 %0, %1, 6, %0" : "=&v"(tid) : "s"(wave_s));
    int bid = blockIdx.x, G = gridDim.x; unsigned lo_ = 0u; asm volatile("" : "+s"(bid), "+s"(G), "+s"(lo_));
    c.lds = lds_k + lo_; c.ptab = (LAS u64*)(c.lds + PTR_OFF); c.gd = (LAS pg8::GD*)(c.lds + GD_OFF);
    c.tid = tid; c.lane = tid & 63; c.wave = __builtin_amdgcn_readfirstlane(tid >> 6); c.bid = bid; c.G = G; c.gw = bid * NWAVES + c.wave; c.NGW = G * NWAVES;
    return c;
}
#define CTX_UNPACK LAS unsigned char* lds = c.lds; LAS u64* ptab = c.ptab; LAS pg8::GD* gd = c.gd; const int tid = c.tid, lane = c.lane, wave = c.wave, bid = c.bid, G = c.G, gw = c.gw, NGW = c.NGW; \
    (void)lds; (void)ptab; (void)gd; (void)tid; (void)lane; (void)wave; (void)bid; (void)G; (void)gw; (void)NGW
__device__ __forceinline__ void ph_pro(const Ctx c) {
    CTX_UNPACK;
    WSDEF;
    LAS float* scr = (LAS float*)(lds + wave * 16384);
    GAS bf16_t* WEIN = (GAS bf16_t*)(ws + WS_WEIN); GAS bf16_t* WOIN = (GAS bf16_t*)(ws + WS_WOIN);
    GAS bf16_t* WEOUT = (GAS bf16_t*)(ws + WS_WEOUT); GAS bf16_t* WOOUT = (GAS bf16_t*)(ws + WS_WOOUT);
    GAS bf16_t* WXQ = (GAS bf16_t*)(ws + WS_WXQ); GAS bf16_t* WXKV = (GAS bf16_t*)(ws + WS_WXKV); GAS bf16_t* WXO = (GAS bf16_t*)(ws + WS_WXO);
    GAS bf16_t* MN = (GAS bf16_t*)(ws + WS_MN); GAS bf16_t* XB = (GAS bf16_t*)(ws + WS_XB); GAS float* LB = (GAS float*)(ws + WS_MISC);
    const GAS float* x = INP(I_X);
    const GAS float* evw = INP(I_EVWIN); const GAS float* odw = INP(I_ODWIN);
    const GAS float* evo = INP(I_EVWOUT); const GAS float* odo = INP(I_ODWOUT);
    const GAS float* odn = INP(I_ODN); const GAS float* xan = INP(I_XAN);
    const GAS float* wq = INP(I_XAWQ); const GAS float* wkv = INP(I_XAWKV); const GAS float* wo = INP(I_XAWO);
    constexpr int NITEMS = (3 * 1536 + 9 * 512 + 4 * 256 + 2 * 512 + 2 * 64) / 2;
    for (int it = gw; it < NITEMS; it += NGW) {
        int r = it;
        if (tr_seg(r, evw, 8192, 1024, 0, 3072, WEIN, 0, nullptr, scr, lane)) continue;
        if (tr_seg(r, evw, 8192, 1024, 6144, 1024, WEIN, 3072, nullptr, scr, lane)) continue;
        if (tr_seg(r, evw, 8192, 1024, 3072, 3072, WEIN, 4096, nullptr, scr, lane)) continue;
        if (tr_seg(r, evw, 8192, 1024, 7168, 1024, WEIN, 7168, nullptr, scr, lane)) continue;
        if (tr_seg(r, odw, 6144, 1024, 0, 1024, WOIN, 0, odn, scr, lane)) continue;
        if (tr_seg(r, odw, 6144, 1024, 4096, 1024, WOIN, 1024, odn, scr, lane)) continue;
        if (tr_seg(r, odw, 6144, 1024, 1024, 3072, WOIN, 2048, odn, scr, lane)) continue;
        if (tr_seg(r, odw, 6144, 1024, 5120, 1024, WOIN, 5120, odn, scr, lane)) continue;
        if (tr_seg(r, evo, 1024, 1024, 0, 1024, WEOUT, 0, nullptr, scr, lane)) continue;
        if (tr_seg(r, evo + (size_t)1024 * 1024, 1024, 1024, 0, 1024, WEOUT + (size_t)1024 * 1024, 0, nullptr, scr, lane)) continue;
        if (tr_seg(r, odo, 1024, 1024, 0, 1024, WOOUT, 0, nullptr, scr, lane)) continue;
        if (tr_seg(r, odo + (size_t)1024 * 1024, 1024, 1024, 0, 1024, WOOUT + (size_t)1024 * 1024, 0, nullptr, scr, lane)) continue;
        if (tr_seg(r, wq, 512, 1024, 0, 512, WXQ, 0, xan, scr, lane)) continue;
        if (tr_seg(r, wq + (size_t)1024 * 512, 512, 1024, 0, 512, WXQ + (size_t)512 * 1024, 0, xan + 1024, scr, lane)) continue;
        if (tr_seg(r, wkv, 1024, 1024, 0, 1024, WXKV, 0, nullptr, scr, lane)) continue;
        if (tr_seg(r, wkv + (size_t)1024 * 1024, 1024, 1024, 0, 1024, WXKV + (size_t)1024 * 1024, 0, nullptr, scr, lane)) continue;
        if (tr_seg(r, wo, 1024, 512, 0, 1024, WXO, 0, nullptr, scr, lane)) continue;
        if (tr_seg(r, wo + (size_t)512 * 1024, 1024, 512, 0, 1024, WXO + (size_t)1024 * 512, 0, nullptr, scr, lane)) continue;
        if (tr_seg(r, INP(I_WA), 128, 1024, 0, 128, (GAS bf16_t*)(ws + WS_WRG), 0, nullptr, scr, lane)) continue;
        tr_seg(r, INP(I_WX), 128, 1024, 0, 128, (GAS bf16_t*)(ws + WS_WRG) + (size_t)128 * 1024, 0, nullptr, scr, lane);
    }
    const GAS float* evn = INP(I_EVN);
    for (int m = gw; m < MROWS; m += 2 * NGW) { rms_row2_bf16(x + (size_t)m * DM, x + (size_t)(m + NGW) * DM, evn, XB + (size_t)m * DM, XB + (size_t)(m + NGW) * DM, lane); }
    const GAS float* mem = INP(I_MEM); const GAS float* xamn = INP(I_XAMN);
    for (int m = gw; m < 2 * NB * MEML; m += NGW) { const int l = m / (NB * MEML), r = m % (NB * MEML);
        rms_row_bf16(mem + (size_t)r * DM, xamn + l * DM, MN + (size_t)m * DM, lane); }
    {
        GAS float* RT = (GAS float*)(ws + WS_XAKV); const GAS int* pos = (const GAS int*)INP(I_POS);
        for (int i = bid * NTHR + tid; i < MROWS * 16; i += G * NTHR) { const int row = i >> 4, j = i & 15; const float ang = (float)pos[row] * powf(500000.f, -(float)j / 16.f);
            *(GAS f32x2*)(RT + (size_t)i * 2) = (f32x2){cosf(ang), sinf(ang)}; }
    }
    {
        const int c = bid * NTHR + tid;
        if (c < 1024) { const GAS float* lbl = INP(I_LBL); const float l0 = lbl[c], l1 = lbl[1024 + c], l2 = lbl[2048 + c];
            const float m = fmaxf(l0, fmaxf(l1, l2)); const float e0 = expf(l0 - m), e1 = expf(l1 - m), e2 = expf(l2 - m); LB[c] = e0 / (e0 + e1 + e2);
            const float nl = -INP(I_LAM)[c]; LB[1024 + c] = (nl > 20.f) ? nl : log1pf(expf(nl)); }
    }
}
template <int ph> __device__ __forceinline__ void ph_gemm(const Ctx c) {
    CTX_UNPACK;
    int K = 1024; if (ph == PH_XO0 || ph == PH_XO1) K = 512;
    if (tid == 0) {
        WSDEF; OUTDEF; HDEF;
        GAS bf16_t* WEIN = (GAS bf16_t*)(ws + WS_WEIN); GAS bf16_t* WOIN = (GAS bf16_t*)(ws + WS_WOIN);
        GAS bf16_t* WEOUT = (GAS bf16_t*)(ws + WS_WEOUT); GAS bf16_t* WOOUT = (GAS bf16_t*)(ws + WS_WOOUT);
        GAS bf16_t* WXQ = (GAS bf16_t*)(ws + WS_WXQ); GAS bf16_t* WXKV = (GAS bf16_t*)(ws + WS_WXKV); GAS bf16_t* WXO = (GAS bf16_t*)(ws + WS_WXO);
        GAS bf16_t* XAKV = (GAS bf16_t*)(ws + WS_XAKV); GAS bf16_t* MN = (GAS bf16_t*)(ws + WS_MN); GAS bf16_t* XB = (GAS bf16_t*)(ws + WS_XB);
        GAS float* SSQ = (GAS float*)(ws + WS_CTL + CTL_SSQ);
#define d0 gd[0]
#define d1 gd[1]
        d1.nM = 1; d1.nN = 1; d1.nunits = 0; d1.diag = 0; d0.rope = nullptr; d0.kms = nullptr; d1.rope = nullptr; d1.kms = nullptr; d0.zshift = 0; d1.zshift = 0;
        GAS bf16_t* STB = (GAS bf16_t*)(ws + WS_ST);
        if (ph == PH_GEMM_A0 || ph == PH_GEMM_B0) {
            d0.A = XB; d0.Bt = WEIN + (ph == PH_GEMM_B0 ? (size_t)4096 * 1024 : 0); d0.nM = 64; d0.nN = 16; d0.kind = 0;
            d0.O = H0; d0.ldc = 1024; d0.split_cols = 1024; d0.split_stride = (long)HSTRIDE; d0.silu_t = 3; d0.ssq_r = nullptr; d0.scale = 1.f;
            if (ph == PH_GEMM_B0) { d0.rope = (const GAS float*)(ws + WS_XAKV); d0.kms = (GAS float*)(ws + WS_CTL + CTL_KMS); d0.zshift = 1;
}
        } else if (ph == PH_GEMM_C1) {
            d0.A = XB; d0.Bt = WOIN; d0.nM = 64; d0.nN = 8; d0.kind = 0;
            d0.O = H0; d0.ldc = 1024; d0.split_cols = 1024; d0.split_stride = (long)(4 * HSTRIDE); d0.silu_t = 1; d0.ssq_r = SSQ + 1 * MROWS; d0.scale = 1.f;

        } else if (ph == PH_GEMM_D1) {
            d0.A = XB; d0.Bt = WOIN + (size_t)2048 * 1024; d0.nM = 64; d0.nN = 16; d0.kind = 0;
            d0.O = H0; d0.ldc = 1024; d0.split_cols = 1024; d0.split_stride = (long)HSTRIDE; d0.silu_t = 3; d0.ssq_r = SSQ + 1 * MROWS; d0.scale = 1.f;
            d1.A = XB; d1.Bt = WOIN; d1.nM = 64; d1.nN = 8; d1.kind = 0; d1.diag = 0; d1.nunits = 512;
            d1.O = (GAS bf16_t*)out; d1.ldc = 1024; d1.split_cols = 1024; d1.split_stride = (long)HSTRIDE; d1.silu_t = 1; d1.ssq_r = SSQ + 1 * MROWS; d1.scale = 1.f;
        } else if (ph == PH_OUT_B0 || ph == PH_OUT_C1) {
            d0.nM = 64; d0.nN = 4; d0.kind = -1; d0.zshift = -1;
            d1.nM = 64; d1.nN = 4; d1.kind = 2; d1.out = out; d1.xb = XB; d1.ssq_w = SSQ + ((ph == PH_OUT_B0) ? 0 : 2) * MROWS;
            if (ph == PH_OUT_B0) { d0.A = Y; d0.Bt = WEOUT; d1.A = STB; d1.Bt = WEOUT + (size_t)1024 * 1024; d1.base = INP(I_X); }
            else { d0.A = (GAS bf16_t*)out + HSTRIDE; d0.Bt = WOOUT; d1.A = Y; d1.Bt = WOOUT + (size_t)1024 * 1024; d1.base = (const GAS float*)XB; }
        } else if (ph == PH_XQ0 || ph == PH_XQ1) {
            const int l = (ph == PH_XQ1);
            d0.A = XB; d0.Bt = WXQ + (size_t)l * 512 * 1024; d0.nM = 64; d0.nN = 2; d0.kind = 0;
            d0.O = H0; d0.ldc = 512; d0.split_cols = 0; d0.silu_t = -1; d0.ssq_r = SSQ + (l ? 2 : 0) * MROWS; d0.scale = QK_SCALE * LOG2E;
            if (l == 0) {
                d1.A = MN; d1.Bt = WXKV; d1.nM = 16; d1.nN = 8; d1.kind = 0; d1.diag = 1;
                d1.O = XAKV; d1.ldc = 1024; d1.split_cols = 1024; d1.split_stride = 0; d1.silu_t = -1; d1.ssq_r = nullptr; d1.scale = 1.f;
                d1.nunits = 64;
            }
        } else {
            const int l = (ph == PH_XO1);
            d0.A = H1; d0.Bt = WXO + (size_t)l * 1024 * 512; d0.nM = 64; d0.nN = 4; d0.kind = l ? ((G == 256) ? 4 : 1) : 2;
            d0.base = (const GAS float*)XB; d0.out = out; d0.xb = XB; d0.ssq_w = SSQ + (l ? 3 : 1) * MROWS;
            if (l) { d0.ssq_r = INP(I_FIN); d0.kms = (GAS float*)(ws + WS_CTL + 8192); }
        }
        d0.nunits = d0.nM * d0.nN;
#undef d0
#undef d1
    }
    __syncthreads();
    if (ph == PH_GEMM_A0 || ph == PH_GEMM_B0 || ph == PH_GEMM_D1 || ph == PH_GEMM_C1) {
        const int grp_ = (bid >> 3) & 3;
        for (int i_ = 0; i_ < grp_; ++i_) { __builtin_amdgcn_s_sleep(36); }
    }
    pg8::Sched S; S.G = G; S.c = bid;
    pg8::gemm_phase<true, true, ph == PH_XO1, (ph == PH_XO0 || ph == PH_OUT_C1 || ph == PH_XO1), (ph == PH_XO1)>(lds, K, S, gd, tid);
}
template <bool PASS_B, bool DRY = false, int KN = 4> __device__ __forceinline__ void ph_hgrn(const Ctx c) {
    CTX_UNPACK;
    WSDEF; HDEF; const GAS float* LB = (const GAS float*)(ws + WS_MISC); GAS float* UST = (GAS float*)(ws + WS_ST); GAS float* DST = (GAS float*)(ws + WS_MISC + 64 * 1024);
    const GAS float* gain = INP(I_EVGAIN);
    for (int item = bid; item < 512; item += G) {
        const int bh = item >> 3, sc = (PASS_B && item >= 256) ? 7 - (item & 7) : (item & 7), b = bh >> 3, hh = bh & 7;
        if (!PASS_B && sc == 7) continue;
        const size_t ro = ((size_t)b * SEQ + sc * 256) * DM + hh * HD;
        if (!PASS_B) lin::passA_item<0>(lds, tid, H1 + ro, H2 + ro, LB + hh * HD, 0.f, (GAS float*)((GAS bf16_t*)UST + (size_t)bh * 8 * 16384), DST + bh * 8 * 128, sc);
        else lin::linatt_item<0, PASS_B, KN>(lds, tid, H0 + ro, H1 + ro, H2 + ro, LB + hh * HD, 0.f, 0.f, (GAS float*)((GAS bf16_t*)UST + (size_t)bh * 8 * 16384), DST + bh * 8 * 128, sc, (DRY ? (GAS bf16_t*)lds_ptr(ptab + 26) : Y) + ro, Y + ro, gain + hh * HD, nullptr);
        __syncthreads();
    }
}
template <bool DRY, int KN = 4> __device__ __forceinline__ void ph_moba(const Ctx c) {
    CTX_UNPACK;
    WSDEF; HDEF; const GAS float* KMEAN = (const GAS float*)(ws + WS_CTL + CTL_KMS); GAS bf16_t* OUTB = (GAS bf16_t*)(ws + WS_ST); (void)DRY;
    for (int u = bid; u < 256; u += G) {
        const int xs = u & 7, sl = u >> 3; const int bh = (G % 8 == 0) ? xs * 8 + (sl >> 2) : (u >> 2), pr = (G % 8 == 0) ? (sl & 3) : (u & 3), b = bh >> 3, hh = bh & 7;
#pragma unroll 1
        for (int half = 0; half < 2; ++half) {
            const int qb = half ? pr : 7 - pr;
            const size_t row0 = (size_t)b * SEQ + qb * 256, bo = (size_t)b * SEQ * DM + hh * HD;
            att::attn_unit<1, KN>(lds, tid, H0 + row0 * DM + hh * HD, DM, QK_SCALE * LOG2E, H1 + bo, H2 + bo, DM, qb, KMEAN + (size_t)b * 8 * DM + hh * HD,
                              OUTB + row0 * DM + hh * HD, DM, OUTB + row0 * DM + hh * HD);
        }
    }
}
template <int ph> __device__ __forceinline__ void ph_xatt(const Ctx c) {
    CTX_UNPACK;
    const int l = (ph == PH_XATT1);
    WSDEF; HDEF;
    if (ph == PH_XATT0) {
        GAS float* TAB = (GAS float*)(ws + WS_MN); const GAS int* pos = (const GAS int*)INP(I_POS);
        for (int i = bid * NTHR + tid; i < MROWS * 64; i += G * NTHR) {
            const int row = i >> 6, j = i & 63; const float ang = (float)pos[row] * powf(10000.f, -(float)j / 64.f);
            *(GAS f32x2*)(TAB + (size_t)i * 2) = (f32x2){cosf(ang), sinf(ang)};
        }
    } const GAS bf16_t* KV = (const GAS bf16_t*)(ws + WS_XAKV) + (size_t)l * 2048 * 1024;
    for (int u = bid; u < 256; u += G) {
        const int b = u >> 5, hh = (u >> 3) & 3, qt = u & 7;
        const size_t row0 = (size_t)b * SEQ + qt * 256;
        att::attn_unit<0>(lds, tid, H0 + row0 * 512 + hh * HD, 512, 1.f, KV + (size_t)b * 256 * 1024 + hh * HD, KV + (size_t)b * 256 * 1024 + 512 + hh * HD, 1024, 0, nullptr,
                          H1 + row0 * 512 + hh * HD, 512, nullptr);
    }
}
__device__ __forceinline__ void ph_rglru(const Ctx c) {
    CTX_UNPACK;
    WSDEF; HDEF;
    OUTDEF;
    rgc::rg_chain(lds, tid, bid, G, (const GAS bf16_t*)out, (GAS bf16_t*)out + HSTRIDE, (const GAS bf16_t*)(ws + WS_WRG), INP(I_CW), INP(I_CB), INP(I_BA), INP(I_BX), (const GAS float*)(ws + WS_MISC + 4096));
}
template <bool PASS_B, bool DRY = false> __device__ __forceinline__ void ph_ret(const Ctx c) {
    CTX_UNPACK;
    WSDEF; HDEF; GAS float* UST = (GAS float*)(ws + WS_ST); const GAS float* TAB = (const GAS float*)(ws + WS_MN);
    const GAS float* gain = INP(I_RGAIN); const GAS float* bias = INP(I_RBIAS);
    for (int item = bid; item < 512; item += G) {
        const int bh = item >> 3, sc = (PASS_B && item >= 256) ? 7 - (item & 7) : (item & 7), b = bh >> 3, hh = bh & 7;
        if (!PASS_B && sc == 7) continue;
        const size_t row0 = (size_t)b * SEQ + sc * 256, ro = row0 * DM + hh * HD;
        const float gam = 1.f - exp2f(-5.f - (float)hh);
        if (!PASS_B) lin::passA_item<1>(lds, tid, H1 + ro, H2 + ro, TAB + row0 * 128, gam, (GAS float*)((GAS bf16_t*)UST + (size_t)bh * 8 * 16384), nullptr, sc);
        else lin::linatt_item<1, PASS_B>(lds, tid, H0 + ro, H1 + ro, H2 + ro, TAB + row0 * 128, gam, exp2f(256.f * __log2f(gam)), (GAS float*)((GAS bf16_t*)UST + (size_t)bh * 8 * 16384), nullptr, sc, (DRY ? (GAS bf16_t*)(ws + WS_XB) : Y) + ro, Y + ro, gain + hh * HD, bias + hh * HD);
        __syncthreads();
    }
}
__device__ __forceinline__ void ph_fin(const Ctx c) {
    CTX_UNPACK;
    OUTDEF; const GAS float* fin = INP(I_FIN);
    for (int m = gw; m < MROWS; m += NGW) {
        GAS f32x4* xr = (GAS f32x4*)(out + (size_t)m * DM) + lane; const GAS f32x4* gr = (const GAS f32x4*)fin + lane;
        f32x4 v[4]; float s = 0.f;
#pragma unroll
        for (int j = 0; j < 4; ++j) { v[j] = xr[64 * j]; s += (v[j].x * v[j].x + v[j].y * v[j].y) + (v[j].z * v[j].z + v[j].w * v[j].w); }
        const float r = rsqrtf(wave_sum(s) * (1.f / DM) + EPS);
#pragma unroll
        for (int j = 0; j < 4; ++j) { const f32x4 g = gr[64 * j]; xr[64 * j] = (f32x4){v[j].x * r * g.x, v[j].y * r * g.y, v[j].z * r * g.z, v[j].w * r * g.w}; }
    }
}

#define IN(k) (ph_lo <= (k) && (k) < ph_hi)
#define SEAM(k) do { if (IN(k) && IN((k) + 1)) xcd_barrier(bar); } while (0)
__global__ void __launch_bounds__(NTHR, 2) mega_fwd(Args args) {
    extern __shared__ __attribute__((aligned(16))) unsigned char lds_raw[];
    LAS unsigned char* lds_k = (LAS unsigned char*)lds_raw;
    const int tid_k = threadIdx.x;
    for (int u = tid_k; u < (LDS_BYTES - RING_BYTES) / 4; u += NTHR) ((LAS unsigned*)(lds_k + RING_BYTES))[u] = 0u;
    __syncthreads();
    if (tid_k == 0) {
        LAS u64* ptab = (LAS u64*)(lds_k + PTR_OFF);
#pragma unroll
        for (int i = 0; i < 26; ++i) ptab[i] = (u64)args.in[i];
        ptab[26] = (u64)args.out; ptab[27] = (u64)args.ws;
    }
    __syncthreads();
    XcdBarrier bar;
    { LAS u64* ptab = (LAS u64*)(lds_k + PTR_OFF); WSDEF; bar = xcd_barrier_post((GAS unsigned*)(ws + WS_CTL) + CW_BAR, (volatile LAS unsigned*)(lds_k + MISC_OFF) + 8); bar.wave = __builtin_amdgcn_readfirstlane(tid_k >> 6); }
    const int ph_lo = args.ph_lo, ph_hi = args.ph_hi;
    const int wave_s = __builtin_amdgcn_readfirstlane(tid_k >> 6);

    if (IN(PH_PRO)) ph_pro(make_ctx(lds_k, wave_s));
    SEAM(PH_PRO);
    if (IN(PH_GEMM_A0)) ph_gemm<PH_GEMM_A0>(make_ctx(lds_k, wave_s));
    SEAM(PH_GEMM_A0);
    if (IN(PH_HGRN_A)) ph_hgrn<false>(make_ctx(lds_k, wave_s));
    SEAM(PH_HGRN_A);
    if (IN(PH_HGRN)) ph_hgrn<true>(make_ctx(lds_k, wave_s));
    SEAM(PH_HGRN);
    if (IN(PH_GEMM_B0)) ph_gemm<PH_GEMM_B0>(make_ctx(lds_k, wave_s));
    SEAM(PH_GEMM_B0);
    if (IN(PH_MOBA)) ph_moba<false>(make_ctx(lds_k, wave_s));
    SEAM(PH_MOBA);
    if (IN(PH_OUT_B0)) ph_gemm<PH_OUT_B0>(make_ctx(lds_k, wave_s));
    SEAM(PH_OUT_B0);
    if (IN(PH_XQ0)) ph_gemm<PH_XQ0>(make_ctx(lds_k, wave_s));
    SEAM(PH_XQ0);
    if (IN(PH_XATT0)) ph_xatt<PH_XATT0>(make_ctx(lds_k, wave_s));
    SEAM(PH_XATT0);
    if (IN(PH_XO0)) ph_gemm<PH_XO0>(make_ctx(lds_k, wave_s));
    SEAM(PH_XO0);
    if (IN(PH_GEMM_D1)) ph_gemm<PH_GEMM_D1>(make_ctx(lds_k, wave_s));
    SEAM(PH_GEMM_D1);
    if (IN(PH_RET_A)) ph_ret<false>(make_ctx(lds_k, wave_s));
    SEAM(PH_RET_A);
    if (IN(PH_RET)) ph_ret<true>(make_ctx(lds_k, wave_s));
    if (IN(PH_RET) && IN(PH_RGLRU)) __syncthreads();
    if (IN(PH_RGLRU)) ph_rglru(make_ctx(lds_k, wave_s));
    SEAM(PH_RGLRU);
    if (IN(PH_OUT_C1)) ph_gemm<PH_OUT_C1>(make_ctx(lds_k, wave_s));
    SEAM(PH_OUT_C1);
    if (IN(PH_XQ1)) ph_gemm<PH_XQ1>(make_ctx(lds_k, wave_s));
    SEAM(PH_XQ1);
    if (IN(PH_XATT1)) ph_xatt<PH_XATT1>(make_ctx(lds_k, wave_s));
    SEAM(PH_XATT1);
    if (IN(PH_XO1)) ph_gemm<PH_XO1>(make_ctx(lds_k, wave_s));
    if (gridDim.x != 256) {
        SEAM(PH_XO1);
        if (IN(PH_FIN)) ph_fin(make_ctx(lds_k, wave_s));
    }
}

extern "C" void kernel_launch(void* const* d_in, const int* in_sizes, int n_in, void* d_out, int out_size, void* d_ws, size_t ws_size, hipStream_t stream) {
    static int grid = 0;
    if (grid == 0) {
        if (n_in != 26 || out_size != MROWS * DM || ws_size < WS_END) { fprintf(stderr, "kernel_launch: unexpected shapes (n_in %d out %d ws %zu)\n", n_in, out_size, ws_size); grid = -1; return; }
        int dev = 0, cus = 0, per_cu = 0;
        hipGetDevice(&dev); hipDeviceGetAttribute(&cus, hipDeviceAttributeMultiprocessorCount, dev);
        hipFuncSetAttribute((const void*)mega_fwd, hipFuncAttributeMaxDynamicSharedMemorySize, LDS_BYTES);
        hipOccupancyMaxActiveBlocksPerMultiprocessor(&per_cu, (const void*)mega_fwd, NTHR, LDS_BYTES);
        if (per_cu < 1) { fprintf(stderr, "kernel_launch: occupancy query says %d blocks/CU\n", per_cu); per_cu = 1; }
        (void)hipGetLastError();
        grid = cus;
    }
    if (grid < 0) return;
    hipMemsetAsync((char*)d_ws + WS_CTL, 0, CTL_ZERO_BYTES, stream);
    Args a{};
    for (int i = 0; i < 26; ++i) a.in[i] = d_in[i];
    a.out = (float*)d_out; a.ws = (unsigned char*)d_ws;
#ifndef MK_PER_PHASE
    a.ph_lo = 0; a.ph_hi = PH_COUNT;
    void* kargs[] = {&a};
    hipError_t e = hipLaunchCooperativeKernel((const void*)mega_fwd, dim3(grid), dim3(NTHR), kargs, LDS_BYTES, stream);
    if (e != hipSuccess) fprintf(stderr, "cooperative launch failed: %s (grid %d)\n", hipGetErrorString(e), grid);
#else
    for (int p = 0; p < PH_COUNT; ++p) { a.ph_lo = p; a.ph_hi = p + 1; hipLaunchKernelGGL(mega_fwd, dim3(grid), dim3(NTHR), LDS_BYTES, stream, a); }
#endif
}
```

```cpp
#include <hip/hip_runtime.h>
#include <cstdio>
#include <cstdint>
#include <math.h>

#define LAS __attribute__((address_space(3)))
#define GAS __attribute__((address_space(1)))
typedef unsigned short bf16_t;
typedef short bf16x8 __attribute__((ext_vector_type(8)));
typedef float f32x4 __attribute__((ext_vector_type(4)));
typedef float f32x2 __attribute__((ext_vector_type(2)));
typedef unsigned u32x4 __attribute__((ext_vector_type(4)));
typedef unsigned u32x2 __attribute__((ext_vector_type(2)));
typedef __bf16 bf16x2_t __attribute__((ext_vector_type(2)));

constexpr int DM = 1024, SEQ = 2048, NB = 8, MEML = 256, HD = 128, MROWS = NB * SEQ;
constexpr float EPS = 1e-6f;
constexpr float QK_SCALE = 0.08838834764831845f;
constexpr float LOG2E = 1.4426950408889634f;

constexpr size_t MiB = 1u << 20;
constexpr size_t WS_CTL = 0, CTL_ZERO_BYTES = 1 * MiB;
constexpr size_t WS_WEIN = 1 * MiB;
constexpr size_t WS_WOIN = 17 * MiB;
constexpr size_t WS_WEOUT = 29 * MiB;
constexpr size_t WS_WOOUT = 33 * MiB;
constexpr size_t WS_WXQ = 37 * MiB;
constexpr size_t WS_WXKV = 39 * MiB;
constexpr size_t WS_WXO = 43 * MiB;
constexpr size_t WS_WRG = 45 * MiB;
constexpr size_t WS_XAKV = 46 * MiB;
constexpr size_t WS_MISC = 54 * MiB;
constexpr size_t WS_MN = 55 * MiB;
constexpr size_t WS_XB = 63 * MiB;
constexpr size_t WS_H0 = 95 * MiB, WS_H1 = 127 * MiB, WS_H2 = 159 * MiB, WS_Y = 191 * MiB;
constexpr size_t WS_ST = 223 * MiB;
constexpr size_t WS_END = 255 * MiB;
constexpr size_t HSTRIDE = 32 * MiB / 2;
constexpr int CW_BAR = 4096;
constexpr size_t CTL_KMS = 512 * 1024;
constexpr size_t CTL_SSQ = 256 * 1024;

constexpr int RING_BYTES = 131072, MISC_OFF = RING_BYTES + 320, PTR_OFF = RING_BYTES + 512  , GD_OFF = RING_BYTES + 1024  , LDS_BYTES = 147456;
constexpr int NWAVES = 8, NTHR = 512;

#define __hip_atomic_fetch_add_(p, v) (void)__hip_atomic_fetch_add((p), (v), __ATOMIC_RELAXED, __HIP_MEMORY_SCOPE_AGENT)
#define RLX_AGENT __ATOMIC_RELAXED, __HIP_MEMORY_SCOPE_AGENT
#define LDS_WAIT() asm volatile("s_waitcnt lgkmcnt(0)" ::: "memory")
__device__ __forceinline__ unsigned pk2(float lo, float hi) { f32x2 v = {lo, hi}; bf16x2_t b = __builtin_convertvector(v, bf16x2_t); return __builtin_bit_cast(unsigned, b); }
__device__ __forceinline__ float bf2f(bf16_t v) { return __uint_as_float(((unsigned)v) << 16); }
__device__ __forceinline__ bf16_t f2bf(float f) { return (bf16_t)(pk2(f, 0.f) & 0xffffu); }
typedef unsigned long long u64;
__device__ __forceinline__ unsigned uni32(unsigned v) { return (unsigned)__builtin_amdgcn_readfirstlane((int)v); }
__device__ __forceinline__ u64 uni64(u64 v) { return ((u64)uni32((unsigned)(v >> 32)) << 32) | uni32((unsigned)v); }
__device__ __forceinline__ float unif(float v) { return __uint_as_float(uni32(__float_as_uint(v))); }
__device__ __forceinline__ void lds_barrier() { asm volatile("s_waitcnt lgkmcnt(0)" ::: "memory"); __builtin_amdgcn_s_barrier(); asm volatile("" ::: "memory"); }
__device__ __forceinline__ float wave_sum(float v) {
#pragma unroll
    for (int o = 1; o < 64; o <<= 1) v += __shfl_xor(v, o);
    return v;
}
__device__ __forceinline__ float wave_max(float v) {
#pragma unroll
    for (int o = 1; o < 64; o <<= 1) v = fmaxf(v, __shfl_xor(v, o));
    return v;
}
__device__ __forceinline__ float sigmoidf_(float x) { return __builtin_amdgcn_rcpf(1.f + __expf(-x)); }
__device__ __forceinline__ float siluf_(float x) { return x * __builtin_amdgcn_rcpf(1.f + __expf(-x)); }

namespace pg8 {
constexpr int BM = 256, BK = 64, HALF = 128, HTB = HALF * BK * 2, STAGE_BYTES = 8 * HTB, NXCD = 8, WGM = 8;
__device__ __forceinline__ int lds_byte(int r, int c) { const int st = (r >> 4) * 2 + (c >> 5), rr = r & 15, cc = c & 31, ob = rr * 64 + cc * 2; return st * 1024 + (ob ^ (((ob >> 9) & 1) << 5)); }
__device__ __forceinline__ void stage_rc(int b, int& R, int& C) { const int st = b / 1024, sb = b % 1024, swz = sb ^ (((sb >> 9) & 1) << 5); R = (st >> 1) * 16 + swz / 64; C = (st & 1) * 32 + (swz % 64) / 2; }
__device__ __forceinline__ int perm32(int rho) { const int n = rho >> 4, i = rho & 15; return 8 * (i >> 2) + 4 * n + (i & 3); }

struct Unit { int g, pm, pn; };
struct GD {
    const GAS bf16_t* A; const GAS bf16_t* Bt; int nM, nN;
    int kind;
    GAS bf16_t* O; int ldc; int split_cols; long split_stride; int silu_t;
    const GAS float* ssq_r; float scale;
    const GAS float* base; GAS float* out; GAS bf16_t* xb; GAS float* ssq_w; int nunits; int diag; const GAS float* rope; GAS float* kms; int zshift; int pad2_;
};
struct Sched {
    int G, c;
    __device__ __forceinline__ bool next(int i, Unit& u, const LAS GD* gd) const {
        const int n0 = (int)uni32((unsigned)gd[0].nunits), n1 = (int)uni32((unsigned)gd[1].nunits);
        if ((int)uni32((unsigned)gd[0].zshift) < 0) {
            long Lp = (long)(i >> 1) * G + c; if (Lp >= (long)n0) return false;
            u.g = i & 1; int wgid = (int)Lp; const int nM = (int)uni32((unsigned)gd[0].nM), nN = (int)uni32((unsigned)gd[0].nN);
            { const int q = n0 / NXCD, r = n0 % NXCD, xcd = wgid % NXCD, off = wgid / NXCD; wgid = (xcd < r ? xcd * (q + 1) : r * (q + 1) + (xcd - r) * q) + off; }
            const int nig = WGM * nN, gid = wgid / nig, fm = gid * WGM, gsz = (nM - fm) < WGM ? (nM - fm) : WGM;
            u.pm = fm + ((wgid % nig) % gsz); u.pn = (wgid % nig) / gsz; return true;
        }
        long L = (long)i * G + c; if (L >= (long)(n0 + n1)) return false;
        const int g = (L >= n0) ? 1 : 0; u.g = g;
        int wgid = (int)L - (g ? n0 : 0); const int nwg = g ? n1 : n0, nM = (int)uni32((unsigned)gd[g].nM), nN = (int)uni32((unsigned)gd[g].nN);
        { const int q = nwg / NXCD, r = nwg % NXCD, xcd = wgid % NXCD, off = wgid / NXCD; wgid = (xcd < r ? xcd * (q + 1) : r * (q + 1) + (xcd - r) * q) + off; }
        if (g && (int)uni32((unsigned)gd[1].diag)) { const int l = wgid >> 5, r = wgid & 31; u.pm = l * 8 + (r & 7); u.pn = l * 4 + (r >> 3); return true; }
        const int nig = WGM * nN, gid = wgid / nig, fm = gid * WGM, gsz = (nM - fm) < WGM ? (nM - fm) : WGM;
        u.pm = fm + ((wgid % nig) % gsz); u.pn = (wgid % nig) / gsz; return true;
    }
};

template <bool BASE16  , bool WOUT  , bool HALFN = false  >
__device__ __forceinline__ void epilogue(const f32x4 (&acc)[2][2][4][2], const LAS GD* dl, const Unit& u, int wr, int wc, int fr, int fq) {
    GD d;
    d.kind = (int)uni32((unsigned)dl->kind);
    if (d.kind == 0) { d.O = (GAS bf16_t*)uni64((u64)dl->O); d.ldc = (int)uni32((unsigned)dl->ldc); d.split_cols = (int)uni32((unsigned)dl->split_cols); d.split_stride = (long)uni64((u64)dl->split_stride);
        d.silu_t = (int)uni32((unsigned)dl->silu_t); d.ssq_r = (const GAS float*)uni64((u64)dl->ssq_r); d.scale = unif(dl->scale); d.rope = (const GAS float*)uni64((u64)dl->rope); d.kms = (GAS float*)uni64((u64)dl->kms); d.zshift = (int)uni32((unsigned)dl->zshift); }
    else { d.base = (const GAS float*)uni64((u64)dl->base); d.out = (GAS float*)uni64((u64)dl->out); d.xb = (GAS bf16_t*)uni64((u64)dl->xb); d.ssq_w = (GAS float*)uni64((u64)dl->ssq_w); }
    const int row0 = u.pm * BM + wr * 64 + fr;
    if (d.kind == 0) {
        int colt = u.pn * (HALFN ? HALF : BM); GAS bf16_t* base = d.O; bool act = false; int tsp = -1;
        if (d.split_cols) { const int t = colt / d.split_cols; base += (size_t)t * d.split_stride; colt -= t * d.split_cols; act = (t == d.silu_t); tsp = t; if (act) base += (size_t)d.zshift * d.split_stride; }
        const int col0 = colt + wc * 32 + 8 * fq;
        const bool do_rope = (d.rope != nullptr) && (tsp == 0 || tsp == 1) && (wc == 0);
        const bool do_km = (d.rope != nullptr) && (tsp == 1);
        float cs_[2][2][4];
#pragma unroll
        for (int bj = 0; bj < 2; ++bj)
#pragma unroll
            for (int n = 0; n < 2; ++n)
#pragma unroll
                for (int e = 0; e < 4; ++e) cs_[bj][n][e] = 0.f;
        float rsv[8];
        { const GAS float* sq_ = d.ssq_r ? d.ssq_r : (const GAS float*)d.O;
#pragma unroll
          for (int it = 0; it < 8; ++it) rsv[it] = sq_[row0 + (it >> 2) * HALF + (it & 3) * 16];
          const bool hs_ = d.ssq_r != nullptr;
#pragma unroll
          for (int it = 0; it < 8; ++it) { const float r_ = d.scale * rsqrtf(fabsf(rsv[it]) * (1.f / 1024.f) + EPS); rsv[it] = hs_ ? r_ : d.scale; } }
#define EPI0_ROWS(ROPE_) do { \
        f32x4 tcn[4]; \
        if (ROPE_) { const GAS f32x4* tp = (const GAS f32x4*)(d.rope + (size_t)row0 * 32 + 16 * (fq & 1)); \
_Pragma("unroll") \
            for (int q4 = 0; q4 < 4; ++q4) tcn[q4] = tp[q4]; } \
_Pragma("unroll") \
        for (int ai = 0; ai < 2; ++ai) \
_Pragma("unroll") \
            for (int m = 0; m < 4; ++m) { \
                const int row = row0 + ai * HALF + m * 16; \
                const float rs = rsv[ai * 4 + m]; \
                GAS bf16_t* rowp = base + (size_t)row * d.ldc + col0; \
                f32x4 tc[4]; \
                if (ROPE_) { \
_Pragma("unroll") \
                    for (int q4 = 0; q4 < 4; ++q4) tc[q4] = tcn[q4]; \
                    if (ai * 4 + m < 7) { const int rown = row0 + ((ai * 4 + m + 1) >> 2) * HALF + ((ai * 4 + m + 1) & 3) * 16; const GAS f32x4* tp = (const GAS f32x4*)(d.rope + (size_t)rown * 32 + 16 * (fq & 1)); \
_Pragma("unroll") \
                        for (int q4 = 0; q4 < 4; ++q4) tcn[q4] = tp[q4]; } } \
_Pragma("unroll") \
                for (int bj = 0; bj < (HALFN ? 1 : 2); ++bj) { \
                    f32x4 v0 = acc[ai][bj][m][0] * rs, v1 = acc[ai][bj][m][1] * rs; \
                    if (act) { \
_Pragma("unroll") \
                        for (int e = 0; e < 4; ++e) { v0[e] = siluf_(v0[e]); v1[e] = siluf_(v1[e]); } \
                    } \
                    if (ROPE_) { \
                        const float sg = (fq < 2) ? -1.f : 1.f; \
_Pragma("unroll") \
                        for (int e = 0; e < 4; ++e) { \
                            const float p0 = __shfl_xor(v0[e], 32), p1 = __shfl_xor(v1[e], 32); \
                            const float c0 = tc[e >> 1][2 * (e & 1)], s0 = tc[e >> 1][2 * (e & 1) + 1], c1 = tc[2 + (e >> 1)][2 * (e & 1)], s1 = tc[2 + (e >> 1)][2 * (e & 1) + 1]; \
                            v0[e] = v0[e] * c0 + sg * p0 * s0; v1[e] = v1[e] * c1 + sg * p1 * s1; \
                        } \
                    } \
                    if (do_km) { \
_Pragma("unroll") \
                        for (int e = 0; e < 4; ++e) { cs_[bj][0][e] += v0[e]; cs_[bj][1][e] += v1[e]; } \
                    } \
                    u32x4 w; w.x = pk2(v0[0], v0[1]); w.y = pk2(v0[2], v0[3]); w.z = pk2(v1[0], v1[1]); w.w = pk2(v1[2], v1[3]); \
                    *(GAS u32x4*)(rowp + bj * HALF) = w; \
                } \
            } \
        } while (0)
        if (do_rope) EPI0_ROWS(true); else EPI0_ROWS(false);
#undef EPI0_ROWS
        if (do_km) {
            GAS float* kp = d.kms + (size_t)u.pm * DM + colt + wc * 32 + 8 * fq;
#pragma unroll
            for (int bj = 0; bj < 2; ++bj)
#pragma unroll
                for (int n = 0; n < 2; ++n)
#pragma unroll
                    for (int e = 0; e < 4; ++e) { float v = cs_[bj][n][e]; v += __shfl_xor(v, 1); v += __shfl_xor(v, 2); v += __shfl_xor(v, 4); v += __shfl_xor(v, 8);
                        if (fr == 0) __hip_atomic_fetch_add_(kp + bj * HALF + 4 * n + e, v); }
        }
    } else {
        const int col0 = u.pn * BM + wc * 32 + 8 * fq;
        f32x4 bq[3][2][2] = {};
#define EPI_BLOAD(set_, it_) do { const size_t offn_ = (size_t)(row0 + ((it_) >> 2) * HALF + ((it_) & 3) * 16) * DM + col0; \
            _Pragma("unroll") for (int bj = 0; bj < 2; ++bj) { \
                if (BASE16) { const u32x4 w_ = *(const GAS u32x4*)((const GAS bf16_t*)d.base + offn_ + bj * HALF); bq[set_][bj][0] = __builtin_bit_cast(f32x4, w_); } \
                else { bq[set_][bj][0] = *(const GAS f32x4*)(d.base + offn_ + bj * HALF); bq[set_][bj][1] = *(const GAS f32x4*)(d.base + offn_ + bj * HALF + 4); } } } while (0)
        EPI_BLOAD(0, 0); EPI_BLOAD(1, 1);
#pragma unroll
        for (int ai = 0; ai < 2; ++ai)
#pragma unroll
            for (int m = 0; m < 4; ++m) {
                const int row = row0 + ai * HALF + m * 16;
                const size_t off = (size_t)row * DM + col0;
                float s = 0.f;
                f32x4 bc[2][2];
#pragma unroll
                for (int bj = 0; bj < 2; ++bj) { bc[bj][0] = bq[(ai * 4 + m) % 3][bj][0]; bc[bj][1] = bq[(ai * 4 + m) % 3][bj][1]; }
                if (ai * 4 + m < 6) EPI_BLOAD((ai * 4 + m + 2) % 3, ai * 4 + m + 2);
#pragma unroll
                for (int bj = 0; bj < 2; ++bj) {
                    f32x4 b0 = bc[bj][0], b1 = bc[bj][1];
                    if (BASE16) { const u32x4 w_ = __builtin_bit_cast(u32x4, bc[bj][0]);
                        b0 = (f32x4){__uint_as_float(w_.x << 16), __uint_as_float(w_.x & 0xffff0000u), __uint_as_float(w_.y << 16), __uint_as_float(w_.y & 0xffff0000u)};
                        b1 = (f32x4){__uint_as_float(w_.z << 16), __uint_as_float(w_.z & 0xffff0000u), __uint_as_float(w_.w << 16), __uint_as_float(w_.w & 0xffff0000u)}; }
                    const f32x4 v0 = acc[ai][bj][m][0] + b0, v1 = acc[ai][bj][m][1] + b1;
                    if (WOUT) { *(GAS f32x4*)(d.out + off + bj * HALF) = v0; *(GAS f32x4*)(d.out + off + bj * HALF + 4) = v1; }
                    if (d.kind == 2) {
                        u32x4 w; w.x = pk2(v0[0], v0[1]); w.y = pk2(v0[2], v0[3]); w.z = pk2(v1[0], v1[1]); w.w = pk2(v1[2], v1[3]);
                        *(GAS u32x4*)(d.xb + off + bj * HALF) = w;
                        s += (v0[0] * v0[0] + v0[1] * v0[1]) + (v0[2] * v0[2] + v0[3] * v0[3]) + (v1[0] * v1[0] + v1[1] * v1[1]) + (v1[2] * v1[2] + v1[3] * v1[3]);
                    }
                }
                if (d.kind == 2) {
                    s += __shfl_xor(s, 16); s += __shfl_xor(s, 32);
                    if (fq == 0) __hip_atomic_fetch_add_(d.ssq_w + row, s);
                }
                asm volatile("" ::: "memory");
            }
#undef EPI_BLOAD
    }
}

__device__ __forceinline__ void epilogue_fin(f32x4 (&acc)[2][2][4][2], const LAS GD* dl, const Unit& u, int wr, int wc, int fr, int fq) {
    GD d;
    d.base = (const GAS float*)uni64((u64)dl->base); d.out = (GAS float*)uni64((u64)dl->out); d.ssq_w = (GAS float*)uni64((u64)dl->ssq_w);
    d.ssq_r = (const GAS float*)uni64((u64)dl->ssq_r); d.kms = (GAS float*)uni64((u64)dl->kms);
    const int row0 = u.pm * BM + wr * 64 + fr;
    {
        const unsigned col0 = (unsigned)(u.pn * BM + wc * 32 + 8 * fq), off0 = (unsigned)row0 * DM + col0;
        u32x4 bn[2];
#pragma unroll
        for (int bj = 0; bj < 2; ++bj) bn[bj] = *(const GAS u32x4*)((const GAS bf16_t*)d.base + (off0 + bj * HALF));
#pragma unroll
        for (int ai = 0; ai < 2; ++ai)
#pragma unroll
            for (int m = 0; m < 4; ++m) {
                float s_ = 0.f;
                u32x4 bc[2];
#pragma unroll
                for (int bj = 0; bj < 2; ++bj) bc[bj] = bn[bj];
                if (ai * 4 + m < 7) { const unsigned offn = off0 + (unsigned)(((ai * 4 + m + 1) >> 2) * HALF + ((ai * 4 + m + 1) & 3) * 16) * DM;
#pragma unroll
                    for (int bj = 0; bj < 2; ++bj) bn[bj] = *(const GAS u32x4*)((const GAS bf16_t*)d.base + (offn + bj * HALF)); }
#pragma unroll
                for (int bj = 0; bj < 2; ++bj) {
                    const u32x4 w_ = bc[bj];
                    const f32x4 b0 = (f32x4){__uint_as_float(w_.x << 16), __uint_as_float(w_.x & 0xffff0000u), __uint_as_float(w_.y << 16), __uint_as_float(w_.y & 0xffff0000u)};
                    const f32x4 b1 = (f32x4){__uint_as_float(w_.z << 16), __uint_as_float(w_.z & 0xffff0000u), __uint_as_float(w_.w << 16), __uint_as_float(w_.w & 0xffff0000u)};
                    f32x4 v0 = acc[ai][bj][m][0] + b0, v1 = acc[ai][bj][m][1] + b1;
                    asm volatile("" : "+v"(v0), "+v"(v1));
                    s_ += (v0[0] * v0[0] + v0[1] * v0[1]) + (v0[2] * v0[2] + v0[3] * v0[3]) + (v1[0] * v1[0] + v1[1] * v1[1]) + (v1[2] * v1[2] + v1[3] * v1[3]);
                    acc[ai][bj][m][0] = v0; acc[ai][bj][m][1] = v1;
                }
                s_ += __shfl_xor(s_, 16); s_ += __shfl_xor(s_, 32);
                if (fq == 0) __hip_atomic_fetch_add_(d.ssq_w + (unsigned)(row0 + ai * HALF + m * 16), s_);
                asm volatile("" ::: "memory");
            }
        asm volatile("s_waitcnt vmcnt(0)" ::: "memory");
        __syncthreads();
        if (wr == 0 && wc == 0 && fr == 0 && fq == 0) {
            GAS unsigned* cnt = (GAS unsigned*)d.kms + 16 * u.pm;
            __builtin_amdgcn_fence(__ATOMIC_RELEASE, "agent"); asm volatile("s_waitcnt vmcnt(0)" ::: "memory");
            (void)__hip_atomic_fetch_add(cnt, 1u, __ATOMIC_RELAXED, __HIP_MEMORY_SCOPE_AGENT);
            unsigned sp_ = 0u; while (__hip_atomic_load(cnt, __ATOMIC_RELAXED, __HIP_MEMORY_SCOPE_AGENT) < 4u && ++sp_ < (1u << 22)) __builtin_amdgcn_s_sleep(1);
            __builtin_amdgcn_fence(__ATOMIC_ACQUIRE, "agent"); asm volatile("s_waitcnt vmcnt(0)" ::: "memory");
        }
        __syncthreads();
        f32x4 gm[2][2]; float rsv[8];
#pragma unroll
        for (int bj = 0; bj < 2; ++bj) { gm[bj][0] = *(const GAS f32x4*)(d.ssq_r + (col0 + bj * HALF)); gm[bj][1] = *(const GAS f32x4*)(d.ssq_r + (col0 + bj * HALF + 4)); }
#pragma unroll
        for (int it = 0; it < 8; ++it) rsv[it] = __hip_atomic_load(d.ssq_w + (unsigned)(row0 + (it >> 2) * HALF + (it & 3) * 16), __ATOMIC_RELAXED, __HIP_MEMORY_SCOPE_AGENT);
#pragma unroll
        for (int it = 0; it < 8; ++it) rsv[it] = rsqrtf(rsv[it] * (1.f / 1024.f) + EPS);
#pragma unroll
        for (int ai = 0; ai < 2; ++ai)
#pragma unroll
            for (int m = 0; m < 4; ++m) {
                const unsigned off = off0 + (unsigned)(ai * HALF + m * 16) * DM;
                const float rs = rsv[ai * 4 + m];
#pragma unroll
                for (int bj = 0; bj < 2; ++bj) {
                    *(GAS f32x4*)(d.out + (off + bj * HALF)) = acc[ai][bj][m][0] * rs * gm[bj][0]; *(GAS f32x4*)(d.out + (off + bj * HALF + 4)) = acc[ai][bj][m][1] * rs * gm[bj][1]; }
            }
    }
}

template <bool ALIGN_EPI, bool SP2, bool FUSE_FIN = false, bool BASE16 = false, bool WOUT = true, bool HALFN = false  >
__device__ __forceinline__ void gemm_phase(LAS unsigned char* lds, const int K, const Sched& S, const LAS GD* gd, const int tid) {
    const int wid = __builtin_amdgcn_readfirstlane(tid >> 6), lane = tid & 63, wr = wid >> 2, wc = wid & 3, fr = lane & 15, fq = lane >> 4;
    const int nt = K / BK;
    unsigned voffA[2], voffB[2];
#pragma unroll
    for (int i = 0; i < 2; ++i) { int R, C; stage_rc(tid * 16 + i * 8192, R, C); const int Rb = (R & ~31) + perm32(R & 31);
        voffA[i] = (unsigned)(R * K + C) * 2u; voffB[i] = (unsigned)(Rb * K + C) * 2u; }
    const size_t kstep = (size_t)(BK * 2);
    const size_t hstep = (size_t)HALF * K * 2;
    const size_t tstep = 2 * hstep;
    const unsigned ldsw = (unsigned)wid * 1024u;
    const int aoff = lds_byte(wr * 64 + fr, fq * 8), boff = lds_byte(wc * 32 + fr, fq * 8);
#define PG8_SA(b, h) (((b) * 2 + (h)) * HTB)
#define PG8_SB(b, h) ((4 + (b) * 2 + (h)) * HTB)
#define PG8_STAGE(bufoff, gbase, voff) do { _Pragma("unroll") for (int _i = 0; _i < 2; ++_i) \
        __builtin_amdgcn_global_load_lds((const GAS unsigned*)((const char*)(gbase) + (voff)[_i]), (LAS unsigned*)(lds + (bufoff) + ldsw + _i * 8192), 16, 0, 0); } while (0)
#define PG8_LDA(dst, b, h) do { _Pragma("unroll") for (int m = 0; m < 4; ++m) _Pragma("unroll") for (int k = 0; k < 2; ++k) dst[m][k] = *(const LAS bf16x8*)(lds + PG8_SA(b, h) + aoff + m * 2048 + k * 1024); } while (0)
#define PG8_LDB(dst, b, h) do { _Pragma("unroll") for (int n = 0; n < 2; ++n) _Pragma("unroll") for (int k = 0; k < 2; ++k) dst[n][k] = *(const LAS bf16x8*)(lds + PG8_SB(b, h) + boff + n * 2048 + k * 1024); } while (0)
#define PG8_MMA(ai, bj, At, Bt) do { __builtin_amdgcn_s_setprio(1); _Pragma("unroll") for (int m = 0; m < 4; ++m) _Pragma("unroll") for (int n = 0; n < 2; ++n) _Pragma("unroll") for (int k = 0; k < 2; ++k) \
        acc[ai][bj][m][n] = __builtin_amdgcn_mfma_f32_16x16x32_bf16(Bt[n][k], At[m][k], acc[ai][bj][m][n], 0, 0, 0); __builtin_amdgcn_s_setprio(0); } while (0)
#define PG8_WAIT_V(n) asm volatile("s_waitcnt vmcnt(" #n ")" ::: "memory")
#define PG8_WAIT_L(n) asm volatile("s_waitcnt lgkmcnt(" #n ")" ::: "memory")
#define PG8_BAR __builtin_amdgcn_s_barrier()
#define PG8_SCHED __builtin_amdgcn_sched_barrier(0)
#define PG8_UA(u) ((const char*)uni64((u64)gd[(u).g].A) + (size_t)(u).pm * tstep)
#define PG8_UB(u) ((const char*)uni64((u64)gd[(u).g].Bt) + (size_t)(u).pn * (HALFN ? hstep : tstep))
    Unit cur, nxt; int ui = 0; bool fin_pend = false;
    if (!S.next(0, cur, gd)) return;
    f32x4 acc[2][2][4][2];
#pragma unroll
    for (int a = 0; a < 2; ++a)
#pragma unroll
        for (int b = 0; b < 2; ++b)
#pragma unroll
            for (int m = 0; m < 4; ++m)
#pragma unroll
                for (int n = 0; n < 2; ++n) acc[a][b][m][n] = (f32x4){0.f, 0.f, 0.f, 0.f};
    bf16x8 At[4][2], B0[2][2], B1[2][2];
    const char* cA = PG8_UA(cur); const char* cB = PG8_UB(cur);
    if constexpr (SP2 && HALFN) {
        PG8_STAGE(PG8_SB(0, 0), cB, voffB); PG8_STAGE(PG8_SA(0, 0), cA, voffA); PG8_STAGE(PG8_SA(0, 1), cA + hstep, voffA);
        if (wr == 1) PG8_BAR;
        PG8_WAIT_V(2); PG8_BAR;
        PG8_STAGE(PG8_SB(1, 0), cB + kstep, voffB); PG8_STAGE(PG8_SA(1, 0), cA + kstep, voffA);
        PG8_WAIT_V(4); PG8_BAR;
    } else
    if constexpr (SP2) {
        PG8_STAGE(PG8_SB(0, 0), cB, voffB); PG8_STAGE(PG8_SB(0, 1), cB + hstep, voffB); PG8_STAGE(PG8_SA(0, 0), cA, voffA); PG8_STAGE(PG8_SA(0, 1), cA + hstep, voffA);
        if (wr == 1) PG8_BAR;
        PG8_WAIT_V(2); PG8_BAR;
        PG8_STAGE(PG8_SB(1, 0), cB + kstep, voffB); PG8_STAGE(PG8_SA(1, 0), cA + kstep, voffA); PG8_STAGE(PG8_SB(1, 1), cB + hstep + kstep, voffB);
        PG8_WAIT_V(6); PG8_BAR;
    } else {
        PG8_STAGE(PG8_SB(0, 0), cB, voffB); PG8_STAGE(PG8_SA(0, 0), cA, voffA); PG8_STAGE(PG8_SB(0, 1), cB + hstep, voffB); PG8_STAGE(PG8_SA(0, 1), cA + hstep, voffA);
        if (wr == 1) PG8_BAR;
        PG8_WAIT_V(4); PG8_BAR;
        PG8_STAGE(PG8_SB(1, 0), cB + kstep, voffB); PG8_STAGE(PG8_SA(1, 0), cA + kstep, voffA); PG8_STAGE(PG8_SB(1, 1), cB + hstep + kstep, voffB);
        PG8_WAIT_V(6); PG8_BAR;
    }
    for (;;) {
        const bool has_next = S.next(ui + 1, nxt, gd);
        const char* nA = has_next ? PG8_UA(nxt) : cA; const char* nB = has_next ? PG8_UB(nxt) : cB;
        for (int t = 0; t < nt; t += 2) {
            const bool last = (t == nt - 2);
            const char* a1 = cA + (size_t)(t + 1) * kstep;
            const char* a2 = last ? nA : cA + (size_t)(t + 2) * kstep; const char* b2 = last ? nB : cB + (size_t)(t + 2) * kstep;
            const char* a3 = a2 + kstep; const char* b3 = b2 + kstep;
            if constexpr (SP2 && HALFN) {
            PG8_LDB(B0, 0, 0); PG8_SCHED; PG8_LDA(At, 0, 0); PG8_STAGE(PG8_SA(1, 1), a1 + hstep, voffA);
            PG8_WAIT_V(6); PG8_WAIT_L(0); PG8_BAR; PG8_MMA(0, 0, At, B0); PG8_BAR; PG8_SCHED;
            PG8_LDA(At, 0, 1); PG8_STAGE(PG8_SB(0, 0), b2, voffB); PG8_STAGE(PG8_SA(0, 0), a2, voffA);
            PG8_WAIT_V(6); PG8_WAIT_L(0); PG8_BAR; PG8_MMA(1, 0, At, B0); PG8_BAR; PG8_SCHED;
            PG8_LDB(B0, 1, 0); PG8_SCHED; PG8_LDA(At, 1, 0); PG8_STAGE(PG8_SA(0, 1), a2 + hstep, voffA);
            PG8_WAIT_V(6); PG8_WAIT_L(0); PG8_BAR; PG8_MMA(0, 0, At, B0); PG8_BAR; PG8_SCHED;
            PG8_LDA(At, 1, 1); PG8_STAGE(PG8_SB(1, 0), b3, voffB); PG8_STAGE(PG8_SA(1, 0), a3, voffA);
            PG8_WAIT_V(6); PG8_WAIT_L(0); PG8_BAR; PG8_MMA(1, 0, At, B0); PG8_BAR; PG8_SCHED;
            } else
            if constexpr (SP2) {
            PG8_LDB(B0, 0, 0); PG8_LDB(B1, 0, 1); PG8_SCHED; PG8_LDA(At, 0, 0); PG8_STAGE(PG8_SA(1, 1), a1 + hstep, voffA);
            PG8_WAIT_V(8); PG8_WAIT_L(0); PG8_BAR; PG8_MMA(0, 0, At, B0); PG8_MMA(0, 1, At, B1); PG8_BAR; PG8_SCHED;
            PG8_LDA(At, 0, 1); PG8_STAGE(PG8_SB(0, 0), b2, voffB); PG8_STAGE(PG8_SB(0, 1), b2 + hstep, voffB); PG8_STAGE(PG8_SA(0, 0), a2, voffA);
            PG8_WAIT_V(8); PG8_WAIT_L(0); PG8_BAR; PG8_MMA(1, 0, At, B0); PG8_MMA(1, 1, At, B1); PG8_BAR; PG8_SCHED;
            PG8_LDB(B0, 1, 0); PG8_LDB(B1, 1, 1); PG8_SCHED; PG8_LDA(At, 1, 0); PG8_STAGE(PG8_SA(0, 1), a2 + hstep, voffA);
            PG8_WAIT_V(8); PG8_WAIT_L(0); PG8_BAR; PG8_MMA(0, 0, At, B0); PG8_MMA(0, 1, At, B1); PG8_BAR; PG8_SCHED;
            PG8_LDA(At, 1, 1); PG8_STAGE(PG8_SB(1, 0), b3, voffB); PG8_STAGE(PG8_SB(1, 1), b3 + hstep, voffB); PG8_STAGE(PG8_SA(1, 0), a3, voffA);
            PG8_WAIT_V(8); PG8_WAIT_L(0); PG8_BAR; PG8_MMA(1, 0, At, B0); PG8_MMA(1, 1, At, B1); PG8_BAR; PG8_SCHED;
            } else {
            PG8_LDB(B0, 0, 0); PG8_SCHED; PG8_LDA(At, 0, 0); PG8_STAGE(PG8_SA(1, 1), a1 + hstep, voffA);
            PG8_WAIT_L(8); PG8_BAR; PG8_WAIT_L(0); PG8_MMA(0, 0, At, B0); PG8_BAR; PG8_SCHED;
            PG8_LDB(B1, 0, 1); PG8_STAGE(PG8_SB(0, 0), b2, voffB);
            PG8_BAR; PG8_WAIT_L(0); PG8_MMA(0, 1, At, B1); PG8_BAR;
            PG8_LDA(At, 0, 1); PG8_STAGE(PG8_SA(0, 0), a2, voffA);
            PG8_BAR; PG8_WAIT_L(0); PG8_MMA(1, 0, At, B0); PG8_BAR; PG8_SCHED;
            PG8_STAGE(PG8_SB(0, 1), b2 + hstep, voffB);
            PG8_WAIT_V(6); PG8_BAR; PG8_MMA(1, 1, At, B1); PG8_BAR;
            PG8_LDB(B0, 1, 0); PG8_SCHED; PG8_LDA(At, 1, 0); PG8_STAGE(PG8_SA(0, 1), a2 + hstep, voffA);
            PG8_WAIT_L(8); PG8_BAR; PG8_WAIT_L(0); PG8_MMA(0, 0, At, B0); PG8_BAR; PG8_SCHED;
            PG8_LDB(B1, 1, 1); PG8_STAGE(PG8_SB(1, 0), b3, voffB);
            PG8_BAR; PG8_WAIT_L(0); PG8_MMA(0, 1, At, B1); PG8_BAR;
            PG8_LDA(At, 1, 1); PG8_STAGE(PG8_SA(1, 0), a3, voffA);
            PG8_BAR; PG8_WAIT_L(0); PG8_MMA(1, 0, At, B0); PG8_BAR; PG8_SCHED;
            PG8_STAGE(PG8_SB(1, 1), b3 + hstep, voffB);
            PG8_WAIT_V(6); PG8_BAR; PG8_MMA(1, 1, At, B1); PG8_BAR;
            }
        }
        const bool epi = (int)uni32((unsigned)gd[cur.g].kind) >= 0;
        if (epi) {
            if constexpr (ALIGN_EPI) { if (wr == 0) PG8_BAR; }
            if (FUSE_FIN && (int)uni32((unsigned)gd[cur.g].kind) == 4) fin_pend = true;
            else {
                epilogue<BASE16, WOUT, HALFN>(acc, gd + cur.g, cur, wr, wc, fr, fq);
#pragma unroll
                for (int a = 0; a < 2; ++a)
#pragma unroll
                    for (int b = 0; b < 2; ++b)
#pragma unroll
                        for (int m = 0; m < 4; ++m)
#pragma unroll
                            for (int n = 0; n < 2; ++n) acc[a][b][m][n] = (f32x4){0.f, 0.f, 0.f, 0.f};
            }
        }
        if (!has_next) break;
        cur = nxt; cA = nA; cB = nB; ++ui;
        if (epi) { if constexpr (ALIGN_EPI) { if (wr == 1) PG8_BAR; } }
    }
    PG8_WAIT_V(0);
    if constexpr (!ALIGN_EPI) { if (wr == 0) PG8_BAR; }
    PG8_BAR;
    if constexpr (FUSE_FIN) { if (fin_pend) epilogue_fin(acc, gd + cur.g, cur, wr, wc, fr, fq); }
#undef PG8_SA
#undef PG8_SB
#undef PG8_STAGE
#undef PG8_LDA
#undef PG8_LDB
#undef PG8_MMA
#undef PG8_WAIT_V
#undef PG8_WAIT_L
#undef PG8_BAR
#undef PG8_SCHED
#undef PG8_UA
#undef PG8_UB
}
}

#define XB_TMO      128
#define XB_XCNT(j)  (256  + 64 * (j))
#define XB_XSUB(j)  (1280 + 64 * (j))
#define XB_XGEN(j)  (2304 + 64 * (j))
#define XB_TOP      3328
#define XB_TOPGEN   3392
#define XCD_BAR_WORDS 3456
#define XB_SPIN_CAP (1u << 18)
__device__ __forceinline__ unsigned xb_ld(GAS unsigned* p)              { return __hip_atomic_load(p, __ATOMIC_RELAXED, __HIP_MEMORY_SCOPE_AGENT); }
__device__ __forceinline__ unsigned xb_add(GAS unsigned* p, unsigned v) { return __hip_atomic_fetch_add(p, v, __ATOMIC_RELAXED, __HIP_MEMORY_SCOPE_AGENT); }
__device__ __forceinline__ unsigned xb_xcc_id() { return (unsigned)__builtin_amdgcn_s_getreg((3 << 11) | 20) & 0xFu; }
#define XB_SPIN(cond, bar) do { unsigned _sp = 0; while (cond) { __builtin_amdgcn_s_sleep(1); \
    if ((++_sp & 255u) == 0u) { if (xb_ld(&(bar)[XB_TMO])) break; if (_sp > XB_SPIN_CAP) { __hip_atomic_fetch_add_(&(bar)[XB_TMO], 1u); break; } } } } while (0)
struct XcdBarrier { GAS unsigned* bar; unsigned x; volatile LAS unsigned* st; int wave; };
__device__ __forceinline__ XcdBarrier xcd_barrier_post(GAS unsigned* bar, volatile LAS unsigned* st) {
    XcdBarrier b; b.bar = bar; b.x = xb_xcc_id(); b.st = st;
    if (threadIdx.x == 0) (void)xb_add(&bar[XB_XCNT(b.x)], 1u);
    return b;
}
__device__ __forceinline__ void xcd_barrier_complete(GAS unsigned* bar, unsigned x, unsigned& nloc, unsigned& nx) {
    const unsigned G = gridDim.x * gridDim.y * gridDim.z;
    unsigned sum, cnt, mine, sp = 0u;
    for (;;) {
        sum = 0u; cnt = 0u; mine = 0u;
#pragma unroll
        for (unsigned j = 0; j < 16; ++j) { const unsigned c = xb_ld(&bar[XB_XCNT(j)]); sum += c; cnt += (c > 0u) ? 1u : 0u; mine = (j == x) ? c : mine; }
        if (sum == G) break;
        __builtin_amdgcn_s_sleep(1);
        if ((++sp & 255u) == 0u) { if (xb_ld(&bar[XB_TMO])) break; if (sp > XB_SPIN_CAP) { __hip_atomic_fetch_add_(&bar[XB_TMO], 1u); break; } }
    }
    nloc = mine > 0u ? mine : 1u; nx = cnt > 0u ? cnt : 1u;
}
__device__ __forceinline__ void xcd_barrier(const XcdBarrier& b) {
    asm volatile("s_waitcnt vmcnt(0)" ::: "memory");
    __syncthreads();
    int ln; asm volatile("v_mbcnt_lo_u32_b32 %0, -1, 0\n\tv_mbcnt_hi_u32_b32 %0, -1, %0" : "=&v"(ln));
    if (b.wave == 0 && ln == 0) {
        GAS unsigned* bar = b.bar; asm volatile("" : "+s"(bar));
        __builtin_amdgcn_s_waitcnt(0);
        unsigned nloc = b.st[0], nx = b.st[1];
        if (nloc == 0u) { xcd_barrier_complete(bar, b.x, nloc, nx); b.st[0] = nloc; b.st[1] = nx; }
        const unsigned old = xb_add(&bar[XB_XSUB(b.x)], 1u);
        const unsigned gen = old / nloc;
        if (old + 1u == (gen + 1u) * nloc) {
            __builtin_amdgcn_fence(__ATOMIC_RELEASE, "agent");
            asm volatile("s_waitcnt vmcnt(0)" ::: "memory");
            const unsigned og = xb_add(&bar[XB_TOP], 1u);
            const unsigned tg = og / nx;
            if (og + 1u == (tg + 1u) * nx) xb_add(&bar[XB_TOPGEN], 1u);
            else XB_SPIN(xb_ld(&bar[XB_TOPGEN]) == tg, bar);
            __builtin_amdgcn_fence(__ATOMIC_ACQUIRE, "agent");
            asm volatile("s_waitcnt vmcnt(0)" ::: "memory");
        } else {
            XB_SPIN(xb_ld(&bar[XB_TOPGEN]) == gen, bar);
            __builtin_amdgcn_fence(__ATOMIC_ACQUIRE, "agent");
            asm volatile("s_waitcnt vmcnt(0)" ::: "memory");
        }
    }
    __syncthreads();
}

struct Args { const void* in[26]; float* out; unsigned char* ws; int ph_lo, ph_hi; };
enum { I_X = 0, I_MEM, I_POS, I_LBL, I_EVN, I_EVWIN, I_EVGAIN, I_EVWOUT, I_ODN, I_ODWIN, I_CW, I_CB, I_WA, I_BA, I_WX, I_BX, I_LAM, I_RGAIN, I_RBIAS, I_ODWOUT,
       I_XAN, I_XAMN, I_XAWQ, I_XAWKV, I_XAWO, I_FIN };

struct TrD { const GAS float* W; GAS bf16_t* WT; const GAS float* gain; int ldw, k0, nsrc, ldt, ndst, kdst; };
__device__ __forceinline__ void tr_load(const TrD& d, f32x4 (&v)[16], float (&g)[16], int lane) {
    const int n4 = lane & 15, kq = lane >> 4;
#pragma unroll
    for (int i = 0; i < 16; ++i) v[i] = *(const GAS f32x4*)(d.W + (size_t)(d.k0 + kq + 4 * i) * d.ldw + d.nsrc + 4 * n4);
    const GAS float* gp = d.gain ? d.gain + d.k0 : d.W;
#pragma unroll
    for (int i = 0; i < 16; ++i) g[i] = gp[kq + 4 * i];
}
__device__ __forceinline__ void tr_store(const TrD& d, const f32x4 (&v)[16], const float (&g)[16], LAS float* scr, int lane) {
    const int n4 = lane & 15, kq = lane >> 4; const bool hg = d.gain != nullptr;
#pragma unroll
    for (int i = 0; i < 16; ++i) { const int kk = kq + 4 * i; const float gg = hg ? g[i] : 1.f; const f32x4 x = v[i] * gg;
        *(LAS f32x4*)(scr + kk * 64 + ((4 * n4 + 8 * (kk >> 3)) & 63)) = x; }
    LDS_WAIT(); asm volatile("" ::: "memory");
    const int c = lane & 7;
#pragma unroll
    for (int j = 0; j < 8; ++j) { const int n = (lane >> 3) + 8 * j; const LAS float* sp = scr + (8 * c) * 64 + ((n + 8 * c) & 63);
        u32x4 o; o.x = pk2(sp[0 * 64], sp[1 * 64]); o.y = pk2(sp[2 * 64], sp[3 * 64]); o.z = pk2(sp[4 * 64], sp[5 * 64]); o.w = pk2(sp[6 * 64], sp[7 * 64]);
        *(GAS u32x4*)(d.WT + (size_t)(d.ndst + n) * d.ldt + d.kdst + 8 * c) = o; }
    LDS_WAIT(); asm volatile("" ::: "memory");
}
__device__ __forceinline__ bool tr_seg(int& r, const GAS float* W, int ldw, int K, int nsrc0, int ncols, GAS bf16_t* WT, int ndst0, const GAS float* gain, TrD& d) {
    const int nblk = ncols / 64, items = (K / 64) * nblk;
    if (r >= items) { r -= items; return false; }
    const int kb = r / nblk, nb = r % nblk;
    d.W = W; d.ldw = ldw; d.k0 = 64 * kb; d.nsrc = nsrc0 + 64 * nb; d.WT = WT; d.ldt = K; d.ndst = ndst0 + 64 * nb; d.kdst = 64 * kb; d.gain = gain;
    return true;
}
__device__ __forceinline__ void rms_row_bf16(const GAS float* xrow, const GAS float* gain, GAS bf16_t* orow, int lane) {
    const GAS f32x4* xr = (const GAS f32x4*)xrow + lane; const GAS f32x4* gr = (const GAS f32x4*)gain + lane;
    f32x4 v[4]; float s = 0.f;
#pragma unroll
    for (int j = 0; j < 4; ++j) { v[j] = xr[64 * j]; s += (v[j].x * v[j].x + v[j].y * v[j].y) + (v[j].z * v[j].z + v[j].w * v[j].w); }
    f32x4 gv[4];
#pragma unroll
    for (int j = 0; j < 4; ++j) gv[j] = gr[64 * j];
    const float r = rsqrtf(wave_sum(s) * (1.f / DM) + EPS);
    GAS u32x2* o8 = (GAS u32x2*)orow + lane;
#pragma unroll
    for (int j = 0; j < 4; ++j) { const f32x4 g = gv[j]; u32x2 w; w.x = pk2(v[j].x * r * g.x, v[j].y * r * g.y); w.y = pk2(v[j].z * r * g.z, v[j].w * r * g.w); o8[64 * j] = w; }
}

__device__ __forceinline__ void rms_row2_bf16(const GAS float* xa, const GAS float* xb, const GAS float* gain, GAS bf16_t* oa, GAS bf16_t* ob, int lane) {
    const GAS f32x4* pa = (const GAS f32x4*)xa + lane; const GAS f32x4* pb = (const GAS f32x4*)xb + lane; const GAS f32x4* gr = (const GAS f32x4*)gain + lane;
    f32x4 va[4], vb[4]; float sa = 0.f, sb = 0.f;
#pragma unroll
    for (int j = 0; j < 4; ++j) { va[j] = pa[64 * j]; vb[j] = pb[64 * j]; }
#pragma unroll
    for (int j = 0; j < 4; ++j) { sa += (va[j].x * va[j].x + va[j].y * va[j].y) + (va[j].z * va[j].z + va[j].w * va[j].w); sb += (vb[j].x * vb[j].x + vb[j].y * vb[j].y) + (vb[j].z * vb[j].z + vb[j].w * vb[j].w); }
    f32x4 gv[4];
#pragma unroll
    for (int j = 0; j < 4; ++j) gv[j] = gr[64 * j];
    const float ra = rsqrtf(wave_sum(sa) * (1.f / DM) + EPS), rb = rsqrtf(wave_sum(sb) * (1.f / DM) + EPS);
    GAS u32x2* o8a = (GAS u32x2*)oa + lane; GAS u32x2* o8b = (GAS u32x2*)ob + lane;
#pragma unroll
    for (int j = 0; j < 4; ++j) { const f32x4 g = gv[j]; u32x2 w; w.x = pk2(va[j].x * ra * g.x, va[j].y * ra * g.y); w.y = pk2(va[j].z * ra * g.z, va[j].w * ra * g.w); o8a[64 * j] = w;
        w.x = pk2(vb[j].x * rb * g.x, vb[j].y * rb * g.y); w.y = pk2(vb[j].z * rb * g.z, vb[j].w * rb * g.w); o8b[64 * j] = w; }
}
enum { PH_PRO = 0, PH_GEMM_A0, PH_HGRN_A, PH_HGRN, PH_GEMM_B0, PH_MOBA, PH_OUT_B0, PH_XQ0, PH_XATT0, PH_XO0,
       PH_GEMM_D1, PH_RET_A, PH_RET, PH_GEMM_C1, PH_RGLRU, PH_OUT_C1, PH_XQ1, PH_XATT1, PH_XO1, PH_FIN, PH_COUNT };

__device__ __forceinline__ const GAS void* lds_ptr(const LAS u64* p) { return (const GAS void*)uni64(*p); }
#define INP(i) ((const GAS float*)lds_ptr(ptab + (i)))
#define WSDEF GAS unsigned char* ws = (GAS unsigned char*)lds_ptr(ptab + 27); (void)ws
#define OUTDEF GAS float* out = (GAS float*)lds_ptr(ptab + 26)
#define HDEF GAS bf16_t* H0 = (GAS bf16_t*)(ws + WS_H0); GAS bf16_t* H1 = (GAS bf16_t*)(ws + WS_H1); GAS bf16_t* H2 = (GAS bf16_t*)(ws + WS_H2); GAS bf16_t* Y = (GAS bf16_t*)(ws + WS_Y); (void)H0; (void)H1; (void)H2; (void)Y


namespace att {
typedef float f32x16 __attribute__((ext_vector_type(16)));
typedef short s16x4 __attribute__((ext_vector_type(4)));
constexpr int KOFF = 0, VOFF = 32768, SCR_OFF = 65536;
__device__ __forceinline__ f32x16 mfma32(bf16x8 a, bf16x8 b, f32x16 c) { return __builtin_amdgcn_mfma_f32_32x32x16_bf16(a, b, c, 0, 0, 0); }
__device__ __forceinline__ u32x2 vtr(const LAS unsigned char* p) { return __builtin_bit_cast(u32x2, __builtin_amdgcn_ds_read_tr16_b64_v4i16((LAS s16x4*)p)); }
__device__ __forceinline__ bf16x8 cat2(u32x2 lo, u32x2 hh) { u32x4 w; w.x = lo.x; w.y = lo.y; w.z = hh.x; w.w = hh.y; return __builtin_bit_cast(bf16x8, w); }
__device__ __forceinline__ float max3f(float a, float b, float c) { float r; asm("v_max3_f32 %0, %1, %2, %3" : "=v"(r) : "v"(a), "v"(b), "v"(c)); return r; }
__device__ __forceinline__ float max2f(float a, float b) { float r; asm("v_max_f32_e32 %0, %1, %2" : "=v"(r) : "v"(a), "v"(b)); return r; }
__device__ __forceinline__ float xhalf_max(float m) { auto rr = __builtin_amdgcn_permlane32_swap(__float_as_uint(m), __float_as_uint(m), false, false); return max2f(__uint_as_float(rr[0]), __uint_as_float(rr[1])); }
__device__ __forceinline__ float xhalf_sum(float m) { auto rr = __builtin_amdgcn_permlane32_swap(__float_as_uint(m), __float_as_uint(m), false, false); return __uint_as_float(rr[0]) + __uint_as_float(rr[1]); }

template <int MODE, int KN = 4>
__device__ __forceinline__ void attn_unit(LAS unsigned char* lds, const int tid, const GAS bf16_t* Qg, const int ldq, const float sc,
                                          const GAS bf16_t* Kg, const GAS bf16_t* Vg, const int ldkv, const int qb, const GAS float* kmean,
                                          GAS bf16_t* Og, const int ldo, const GAS bf16_t* Zg) {
    const int lane = tid & 63, wave = __builtin_amdgcn_readfirstlane(tid >> 6), q32 = lane & 31, hi = lane >> 5;
    const int qrow = wave * 32 + q32;
    bf16x8 qf[8];
    { const GAS bf16_t* qp = Qg + (size_t)qrow * ldq + 8 * hi;
#pragma unroll
      for (int ks = 0; ks < 8; ++ks) qf[ks] = *(const GAS bf16x8*)(qp + 16 * ks); }
    const int drow = wave * 8 + (lane >> 4), dpc = lane & 15;
    const int ksrc0 = (dpc ^ (drow & 15)) * 8, ksrc1 = (dpc ^ ((drow + 4) & 15)) * 8;
    const int vsrc0 = ((((dpc >> 2) ^ (drow & 3)) << 2) | (dpc & 3)) * 8, vsrc1 = ((((dpc >> 2) ^ ((drow + 4) & 3)) << 2) | (dpc & 3)) * 8;
    const int ntiles = MODE == 1 ? 4 * (qb + 1) : 4;
#define ATT_KROW(tt) (MODE == 1 ? ((((tt) < 4) ? qb : ((tt) >> 2) - 1) * 256 + 64 * ((tt) & 3)) : 64 * (tt))
#define ATT_DMA(tt, buf) do { const size_t r0 = (size_t)(ATT_KROW(tt) + drow) * ldkv; LAS unsigned char* kd = lds + KOFF + (buf) * 16384 + wave * 2048; LAS unsigned char* vd = lds + VOFF + (buf) * 16384 + wave * 2048; \
        __builtin_amdgcn_global_load_lds((const GAS unsigned*)(Kg + r0 + ksrc0), (LAS unsigned*)kd, 16, 0, 0); __builtin_amdgcn_global_load_lds((const GAS unsigned*)(Kg + r0 + (size_t)4 * ldkv + ksrc1), (LAS unsigned*)(kd + 1024), 16, 0, 0); \
        __builtin_amdgcn_global_load_lds((const GAS unsigned*)(Vg + r0 + vsrc0), (LAS unsigned*)vd, 16, 0, 0); __builtin_amdgcn_global_load_lds((const GAS unsigned*)(Vg + r0 + (size_t)4 * ldkv + vsrc1), (LAS unsigned*)(vd + 1024), 16, 0, 0); } while (0)
    ATT_DMA(0, 0);
    unsigned selmask = 0u;
    if (MODE == 1) {
        LAS float* km = (LAS float*)(lds + SCR_OFF);
        for (int i = tid; i < 8 * 128; i += NTHR) km[i] = kmean[(i >> 7) * DM + (i & 127)] * (1.f / 256.f);
        __syncthreads();
        float g[8];
#pragma unroll
        for (int n = 0; n < 8; ++n) g[n] = 0.f;
#pragma unroll
        for (int ks = 0; ks < 8; ++ks) {
            float qv[8];
#pragma unroll
            for (int j = 0; j < 8; ++j) qv[j] = bf2f((bf16_t)qf[ks][j]);
#pragma unroll
            for (int n = 0; n < 8; ++n) {
                const f32x4 k0 = *(const LAS f32x4*)(km + n * 128 + 16 * ks + 8 * hi), k1 = *(const LAS f32x4*)(km + n * 128 + 16 * ks + 8 * hi + 4);
                g[n] += (qv[0] * k0[0] + qv[1] * k0[1]) + (qv[2] * k0[2] + qv[3] * k0[3]) + (qv[4] * k1[0] + qv[5] * k1[1]) + (qv[6] * k1[2] + qv[7] * k1[3]);
            }
        }
#pragma unroll
        for (int n = 0; n < 8; ++n) { g[n] = xhalf_sum(g[n]); if (n >= qb) g[n] = -INFINITY; }
        const int nsel = qb < 3 ? qb : 3;
#pragma unroll
        for (int i = 0; i < 3; ++i) {
            int best = 0; float bv = -INFINITY;
#pragma unroll
            for (int n = 0; n < 8; ++n) if (g[n] > bv) { bv = g[n]; best = n; }
            if (i < nsel) selmask |= 1u << best;
#pragma unroll
            for (int n = 0; n < 8; ++n) if (n == best) g[n] = -INFINITY;
        }
    }
    int kaddr[8];
#pragma unroll
    for (int ks = 0; ks < 8; ++ks) kaddr[ks] = q32 * 256 + (((2 * ks + hi) ^ (q32 & 15)) << 4);
    int vaddr[4];
    { const int x = (lane >> 2) & 3, rowl = 4 * hi + ((lane >> 2) & 3);
#pragma unroll
      for (int dvt = 0; dvt < 4; ++dvt) vaddr[dvt] = rowl * 256 + ((dvt ^ x) << 6) + 32 * ((lane >> 4) & 1) + 8 * (lane & 3); }
    f32x16 o[4];
#pragma unroll
    for (int d = 0; d < 4; ++d)
#pragma unroll
        for (int r = 0; r < 16; ++r) o[d][r] = 0.f;
    float m_run = -1e30f, l_run = 0.f;
    asm volatile("s_waitcnt vmcnt(0)" ::: "memory");
    __syncthreads();
    for (int tt = 0; tt < ntiles; ++tt) {
        const int buf = tt & 1;
        if (tt + 1 < ntiles) ATT_DMA(tt + 1, buf ^ 1);
        bool active = true;
        if (MODE == 1) { if (tt < 4) active = (64 * tt <= wave * 32 + 31); }
        if (active && KN >= 2) {
            const LAS unsigned char* kb = lds + KOFF + buf * 16384; const LAS unsigned char* vb = lds + VOFF + buf * 16384;
            f32x16 p0, p1;
#pragma unroll
            for (int r = 0; r < 16; ++r) { p0[r] = 0.f; p1[r] = 0.f; }
            { bf16x8 ka[8], kc[8];
#pragma unroll
              for (int ks = 0; ks < 8; ++ks) { ka[ks] = *(const LAS bf16x8*)(kb + kaddr[ks]); kc[ks] = *(const LAS bf16x8*)(kb + 8192 + kaddr[ks]); }
#pragma unroll
              for (int ks = 0; ks < 8; ++ks) { p0 = mfma32(ka[ks], qf[ks], p0); p1 = mfma32(kc[ks], qf[ks], p1); } }
            if (KN >= 3) {
            float moff = 0.f;
            if (MODE == 1) {
                if (tt < 4) {
                    const int kb0 = 64 * tt + 4 * hi;
#pragma unroll
                    for (int r = 0; r < 16; ++r) { const int kk = kb0 + (r & 3) + 8 * (r >> 2); if (kk > qrow) p0[r] = -INFINITY; if (kk + 32 > qrow) p1[r] = -INFINITY; }
                } else if (!((selmask >> ((tt >> 2) - 1)) & 1u)) moff = -INFINITY;
            }
            float mt, mb;
            { float a = max3f(p0[0], p0[1], p1[0]), b = max3f(p0[2], p0[3], p1[1]); a = max3f(a, p1[2], p1[3]);
#pragma unroll
              for (int r = 4; r < 16; r += 4) { a = max3f(a, p0[r], p0[r + 1]); b = max3f(b, p0[r + 2], p0[r + 3]); a = max3f(a, p1[r], p1[r + 1]); b = max3f(b, p1[r + 2], p1[r + 3]); }
              mt = max2f(a, b) + moff; mb = 0.f; (void)mb; }
            mt = xhalf_max(mt) * sc;
            if (__any(mt > m_run + 8.f)) {
                const float mn = fmaxf(m_run, mt); const float alpha = __builtin_amdgcn_exp2f(m_run - mn);
#pragma unroll
                for (int d = 0; d < 4; ++d)
#pragma unroll
                    for (int r = 0; r < 16; ++r) o[d][r] *= alpha;
                l_run *= alpha; m_run = mn;
            }
            float ls = 0.f;
            const float nm = moff - m_run;
            {
                const f32x2 sc2 = (f32x2){sc, sc}, nm2 = (f32x2){nm, nm}; f32x2 ls2 = (f32x2){0.f, 0.f};
#pragma unroll
                for (int r = 0; r < 16; r += 2) {
                    const f32x2 t0 = (f32x2){p0[r], p0[r + 1]} * sc2 + nm2, t1 = (f32x2){p1[r], p1[r + 1]} * sc2 + nm2;
                    const f32x2 e0 = (f32x2){__builtin_amdgcn_exp2f(t0.x), __builtin_amdgcn_exp2f(t0.y)}, e1 = (f32x2){__builtin_amdgcn_exp2f(t1.x), __builtin_amdgcn_exp2f(t1.y)};
                    p0[r] = e0.x; p0[r + 1] = e0.y; p1[r] = e1.x; p1[r + 1] = e1.y; ls2 += e0 + e1; }
                ls = ls2.x + ls2.y; }
            l_run += ls;
            if (KN >= 4) {
            bf16x8 pa[2][2];
#pragma unroll
            for (int s2 = 0; s2 < 2; ++s2) {
                u32x4 w0, w1;
                w0.x = pk2(p0[8 * s2 + 0], p0[8 * s2 + 1]); w0.y = pk2(p0[8 * s2 + 2], p0[8 * s2 + 3]); w0.z = pk2(p0[8 * s2 + 4], p0[8 * s2 + 5]); w0.w = pk2(p0[8 * s2 + 6], p0[8 * s2 + 7]);
                w1.x = pk2(p1[8 * s2 + 0], p1[8 * s2 + 1]); w1.y = pk2(p1[8 * s2 + 2], p1[8 * s2 + 3]); w1.z = pk2(p1[8 * s2 + 4], p1[8 * s2 + 5]); w1.w = pk2(p1[8 * s2 + 6], p1[8 * s2 + 7]);
                pa[0][s2] = __builtin_bit_cast(bf16x8, w0); pa[1][s2] = __builtin_bit_cast(bf16x8, w1);
            }
#define ATT_VLOAD(dst, g) do { _Pragma("unroll") for (int dvt = 0; dvt < 4; ++dvt) { const LAS unsigned char* vp = vb + vaddr[dvt] + (((g) >> 1) * 32 + ((g) & 1) * 16) * 256; dst[dvt] = cat2(vtr(vp), vtr(vp + 8 * 256)); } } while (0)
#define ATT_PV(src, g) do { _Pragma("unroll") for (int dvt = 0; dvt < 4; ++dvt) o[dvt] = mfma32(src[dvt], pa[(g) >> 1][(g) & 1], o[dvt]); } while (0)
            { bf16x8 vA[4], vB[4];
              ATT_VLOAD(vA, 0); ATT_VLOAD(vB, 1); ATT_PV(vA, 0); ATT_VLOAD(vA, 2); ATT_PV(vB, 1); ATT_VLOAD(vB, 3); ATT_PV(vA, 2); ATT_PV(vB, 3); }
#undef ATT_VLOAD
#undef ATT_PV
            } else { asm volatile("" :: "v"(p0), "v"(p1)); }
            } else { asm volatile("" :: "v"(p0), "v"(p1)); }
        }
        asm volatile("s_waitcnt vmcnt(0)" ::: "memory");
        __syncthreads();
    }
    const float inv = 1.f / xhalf_sum(l_run);
    GAS bf16_t* orow = Og + (size_t)qrow * ldo + 4 * hi;
    const GAS bf16_t* zrow = (Zg ? Zg : (const GAS bf16_t*)Og) + (size_t)qrow * ldo + 4 * hi;
    u32x2 zz[16];
#pragma unroll
    for (int i = 0; i < 16; ++i) zz[i] = *(const GAS u32x2*)(zrow + (i >> 2) * 32 + 8 * (i & 3));
    const bool hz = Zg != nullptr;
#pragma unroll
    for (int dvt = 0; dvt < 4; ++dvt)
#pragma unroll
        for (int g4 = 0; g4 < 4; ++g4) {
            float v0 = o[dvt][4 * g4 + 0] * inv, v1 = o[dvt][4 * g4 + 1] * inv, v2 = o[dvt][4 * g4 + 2] * inv, v3 = o[dvt][4 * g4 + 3] * inv;
            const int col = dvt * 32 + 8 * g4;
            const u32x2 z = zz[dvt * 4 + g4];
            v0 *= hz ? __uint_as_float(z.x << 16) : 1.f; v1 *= hz ? __uint_as_float(z.x & 0xffff0000u) : 1.f; v2 *= hz ? __uint_as_float(z.y << 16) : 1.f; v3 *= hz ? __uint_as_float(z.y & 0xffff0000u) : 1.f;
            u32x2 w; w.x = pk2(v0, v1); w.y = pk2(v2, v3);
            *(GAS u32x2*)(orow + col) = w;
        }
#undef ATT_KROW
#undef ATT_DMA
}
}

namespace lin {
using att::f32x16; using att::mfma32; using att::vtr; using att::xhalf_sum;
constexpr int XR = 0  , QR = 32768  , VT = 65536  , QT = 98304, KT = 114688, TOT = RING_BYTES + 2048  , EREF = TOT + 4096, ELAST = EREF + 512, SSQ = ELAST + 512, SSQ2 = SSQ + 1024, DSTG = RING_BYTES + 12288  ;
__device__ __forceinline__ int swz(int row) { return ((row & 3) << 2) | ((row >> 2) & 3); }
__device__ __forceinline__ int off16(int row, int ch) { return row * 256 + ((ch ^ swz(row)) << 4); }
__device__ __forceinline__ int offb(int row, int colbyte) { return off16(row, colbyte >> 4) + (colbyte & 15); }
__device__ __forceinline__ bf16x8 pack8(const f32x16& p, int s2) {
    u32x4 w; w.x = pk2(p[8 * s2 + 0], p[8 * s2 + 1]); w.y = pk2(p[8 * s2 + 2], p[8 * s2 + 3]); w.z = pk2(p[8 * s2 + 4], p[8 * s2 + 5]); w.w = pk2(p[8 * s2 + 6], p[8 * s2 + 7]);
    return __builtin_bit_cast(bf16x8, w);
}
__device__ __forceinline__ bf16x8 permfrag(const LAS unsigned char* tile, int R, int ks, int pb) {
    const u32x2 lo = *(const LAS u32x2*)(tile + R * 256 + (pb ^ ((2 * ks) << 4))), hh = *(const LAS u32x2*)(tile + R * 256 + (pb ^ ((2 * ks + 1) << 4)));
    u32x4 w; w.x = lo.x; w.y = lo.y; w.z = hh.x; w.w = hh.y; return __builtin_bit_cast(bf16x8, w);
}
__device__ __forceinline__ bf16x8 trfrag1(const LAS unsigned char* tile, int R, int C, int tb1) {
    return att::cat2(vtr(tile + R * 256 + (tb1 ^ (C << 6))), vtr(tile + (R + 8) * 256 + (tb1 ^ ((C << 6) | 32))));
}
__device__ __forceinline__ bf16x8 trfrag2(const LAS unsigned char* tile, int R, int C, int tb2) {
    return att::cat2(vtr(tile + R * 256 + (tb2 ^ (C << 6))), vtr(tile + (R + 4) * 256 + (tb2 ^ ((C << 6) | 16))));
}

template <int KIND  , bool PASS_B, int KN = 4>
__device__ __forceinline__ void linatt_item(LAS unsigned char* lds, const int tid, const GAS bf16_t* Qg, const GAS bf16_t* Xg, const GAS bf16_t* Vg,
                                            const GAS float* aux, const float gam, const float gsc, GAS float* Ubh, GAS float* Dbh, const int sc, GAS bf16_t* Yg, const GAS bf16_t* Zg, const GAS float* gain, const GAS float* bias) {
    const int lane = tid & 63, wave = __builtin_amdgcn_readfirstlane(tid >> 6), q32 = lane & 31, hi = lane >> 5, ct = wave & 1, dt = wave >> 1;
    const int pb_k = q32 * 256 + (swz(q32) << 4) + 8 * hi;
    const int x_ = (lane >> 2) & 3, gl_ = 2 * ((lane >> 4) & 1) + ((lane & 3) >> 1);
    const int tb1_k = (4 * hi + x_) * 256 + (x_ << 6) + ((gl_ ^ hi) << 4) + 8 * (lane & 1);
    const int tb2_k = (8 * hi + x_) * 256 + (x_ << 6) + ((gl_ ^ (2 * hi)) << 4) + 8 * (lane & 1);
    f32x16 S[4];
#pragma unroll
    for (int t = 0; t < 4; ++t)
#pragma unroll
        for (int r = 0; r < 16; ++r) S[t][r] = 0.f;
    float dprod0 = 1.f, dprod1 = 1.f;
#define LIN_DMA(chk, buf, ln) do { const int drow = wave * 8 + ((ln) >> 4), dch = (ln) & 15; const int vsr0 = (dch ^ swz(drow)) * 8, vsr1 = (dch ^ swz(drow + 4)) * 8; \
        const unsigned r0 = (unsigned)((chk) * 64 + drow) * DM; const int ld_ = (buf) * 16384 + wave * 2048; \
        __builtin_amdgcn_global_load_lds((const GAS unsigned*)(Xg + (r0 + dch * 8)), (LAS unsigned*)(lds + XR + ld_), 16, 0, 0); __builtin_amdgcn_global_load_lds((const GAS unsigned*)(Xg + (r0 + 4 * DM + dch * 8)), (LAS unsigned*)(lds + XR + ld_ + 1024), 16, 0, 0); \
        if (PASS_B) { __builtin_amdgcn_global_load_lds((const GAS unsigned*)(Qg + (r0 + dch * 8)), (LAS unsigned*)(lds + QR + ld_), 16, 0, 0); __builtin_amdgcn_global_load_lds((const GAS unsigned*)(Qg + (r0 + 4 * DM + dch * 8)), (LAS unsigned*)(lds + QR + ld_ + 1024), 16, 0, 0); } \
        __builtin_amdgcn_global_load_lds((const GAS unsigned*)(Vg + (r0 + vsr0)), (LAS unsigned*)(lds + VT + ld_), 16, 0, 0); __builtin_amdgcn_global_load_lds((const GAS unsigned*)(Vg + (r0 + 4 * DM + vsr1)), (LAS unsigned*)(lds + VT + ld_ + 1024), 16, 0, 0); } while (0)
    f32x2 lb2 = (f32x2){0.f, 0.f}; if (KIND == 0) lb2 = *(const GAS f32x2*)(aux + 2 * (tid & 63));
    { int l0 = lane; asm volatile("" : "+v"(l0)); LIN_DMA(0, 0, l0); }
    if (PASS_B) {
        u32x2 ua[16], uc[16];
#define LIN_UISSUE(dst, j_) do { const GAS bf16_t* up_ = (const GAS bf16_t*)Ubh + (size_t)(j_) * 16384 + (dt * 4 * 64 + lane) * 16; \
            _Pragma("unroll") for (int t = 0; t < 4; ++t) _Pragma("unroll") for (int g4 = 0; g4 < 4; ++g4) dst[4 * t + g4] = *(const GAS u32x2*)(up_ + t * 1024 + 4 * g4); } while (0)
#define LIN_UCOMB(src, j_) do { _Pragma("unroll") for (int t = 0; t < 4; ++t) _Pragma("unroll") for (int g4 = 0; g4 < 4; ++g4) { \
            f32x4 d4; if (KIND == 0) d4 = *(const LAS f32x4*)(lds + DSTG + ((j_) * 128 + 32 * t + 8 * g4 + 4 * hi) * 4); else d4 = (f32x4){gsc, gsc, gsc, gsc}; \
            const u32x2 ub = src[4 * t + g4]; \
            const f32x4 u4 = (f32x4){__uint_as_float(ub.x << 16), __uint_as_float(ub.x & 0xffff0000u), __uint_as_float(ub.y << 16), __uint_as_float(ub.y & 0xffff0000u)}; \
            _Pragma("unroll") for (int e = 0; e < 4; ++e) S[t][4 * g4 + e] = d4[e] * S[t][4 * g4 + e] + u4[e]; } } while (0)
        if (sc > 0) LIN_UISSUE(ua, 0);
        if (KIND == 0) {
            for (int i = tid; i < sc * 128; i += NTHR) ((LAS float*)(lds + DSTG))[i] = Dbh[i];
            lds_barrier();
        }
        for (int j = 0; j < sc; j += 2) {
            asm volatile("" ::: "memory");
            if (j + 1 < sc) LIN_UISSUE(uc, j + 1);
            asm volatile("" ::: "memory");
            LIN_UCOMB(ua, j);
            if (j + 1 < sc) {
                asm volatile("" ::: "memory");
                if (j + 2 < sc) LIN_UISSUE(ua, j + 2);
                asm volatile("" ::: "memory");
                LIN_UCOMB(uc, j + 1);
            }
        }
#undef LIN_UISSUE
#undef LIN_UCOMB
    }
    asm volatile("s_waitcnt vmcnt(0)" ::: "memory");
    lds_barrier();
#pragma unroll 1
    for (int chk = 0; chk < 4; ++chk) {
        int pb = pb_k, tb1 = tb1_k, tb2 = tb2_k, qm = q32 - 4 * hi;
        int tid_c = tid;
        asm volatile("" : "+v"(pb), "+v"(tb1), "+v"(tb2), "+v"(qm), "+v"(tid_c));
        const int bo = (chk & 1) * 16384;
        if (KIND == 0) {
            const int dkp = tid_c & 63, tg = __builtin_amdgcn_readfirstlane(tid_c >> 6);
            f32x2 pl[8], kk[8]; f32x2 pp_ = (f32x2){1.f, 1.f};
            const f32x2 one2_ = (f32x2){1.f, 1.f}, oml_ = one2_ - lb2, nl2_ = (f32x2){-LOG2E, -LOG2E};
            const LAS unsigned char* xrp = lds + XR + bo + tg * 2048 + dkp * 4;
#pragma unroll
            for (int i = 0; i < 8; ++i) { const unsigned xw = *(const LAS unsigned*)(xrp + i * 256);
                const f32x2 t_ = (f32x2){__uint_as_float(xw << 16), __uint_as_float(xw & 0xffff0000u)} * nl2_;
                const f32x2 d_ = (f32x2){__builtin_amdgcn_exp2f(t_.x), __builtin_amdgcn_exp2f(t_.y)} + one2_;
                const f32x2 f_ = lb2 + oml_ * (f32x2){__builtin_amdgcn_rcpf(d_.x), __builtin_amdgcn_rcpf(d_.y)};
                pp_ = pp_ * f_; pl[i] = pp_; kk[i] = one2_ - f_; }
            *(LAS f32x2*)(lds + TOT + (tg * 128 + 2 * dkp) * 4) = pp_;
            lds_barrier();
            f32x2 T[8];
#pragma unroll
            for (int g = 0; g < 8; ++g) T[g] = *(const LAS f32x2*)(lds + TOT + (g * 128 + 2 * dkp) * 4);
            f32x2 R_ = one2_;
#pragma unroll
            for (int g = 0; g < 8; ++g) { const bool in = (tg < 4) ? (g >= tg && g < 4) : (g >= 4 && g < tg); if (in) R_ = R_ * T[g]; }
            if (tg < 4) R_ = (f32x2){__builtin_amdgcn_rcpf(R_.x), __builtin_amdgcn_rcpf(R_.y)};
            const int wb = tg * 2048 + ((dkp >> 2) << 4) + (dkp & 3) * 4;
            const LAS unsigned char* qrp = lds + QR + bo + tg * 2048 + dkp * 4;
#pragma unroll
            for (int i = 0; i < 8; ++i) { const f32x2 E_ = pl[i] * R_;
                const int o = (wb ^ (swz(8 * tg + i) << 4)) + i * 256;
                const f32x2 kt_ = kk[i] * (f32x2){__builtin_amdgcn_rcpf(E_.x), __builtin_amdgcn_rcpf(E_.y)};
                *(LAS unsigned*)(lds + KT + o) = pk2(kt_.x, kt_.y);
                if (PASS_B) { const unsigned qw = *(const LAS unsigned*)(qrp + i * 256); const f32x2 qe_ = (f32x2){__uint_as_float(qw << 16), __uint_as_float(qw & 0xffff0000u)} * E_;
                    *(LAS unsigned*)(lds + QT + o) = pk2(qe_.x, qe_.y); } }
            if (tg == 0) { const f32x2 er_ = (T[0] * T[1]) * (T[2] * T[3]), el_ = (T[4] * T[5]) * (T[6] * T[7]);
                *(LAS f32x2*)(lds + EREF + dkp * 8) = er_; *(LAS f32x2*)(lds + ELAST + dkp * 8) = el_; dprod0 *= er_.x * el_.x; dprod1 *= er_.y * el_.y; }
        } else {
            const int dp = tid_c & 31, tg = tid_c >> 5;
            const GAS float* cst = aux + (size_t)(chk * 64 + 4 * tg) * 128 + dp * 4;
            const float l2g = __log2f(gam);
            const LAS unsigned char* xrp = lds + XR + bo + tg * 1024 + dp * 4; const LAS unsigned char* qrp = lds + QR + bo + tg * 1024 + dp * 4;
            const int wb = tg * 1024 + (dp & 3) * 4;
#pragma unroll
            for (int i = 0; i < 4; ++i) { const int s_ = 4 * tg + i;
                const f32x4 cs = *(const GAS f32x4*)(cst + (size_t)i * 128);
                const float dq = exp2f((float)(s_ - 31) * l2g), dkf = QK_SCALE * exp2f((float)(31 - s_) * l2g);
                const int sw = ((i & 3) << 2) | (tg & 3), olo = wb + i * 256 + (((dp >> 2) ^ sw) << 4), ohi = wb + i * 256 + ((((dp >> 2) + 8) ^ sw) << 4);
                { const unsigned lo = *(const LAS unsigned*)(xrp + i * 256), hh = *(const LAS unsigned*)(xrp + i * 256 + 128);
                  const float a0 = __uint_as_float(lo << 16), a1 = __uint_as_float(lo & 0xffff0000u), b0 = __uint_as_float(hh << 16), b1 = __uint_as_float(hh & 0xffff0000u);
                  *(LAS unsigned*)(lds + KT + olo) = pk2((a0 * cs[0] - b0 * cs[1]) * dkf, (a1 * cs[2] - b1 * cs[3]) * dkf);
                  *(LAS unsigned*)(lds + KT + ohi) = pk2((b0 * cs[0] + a0 * cs[1]) * dkf, (b1 * cs[2] + a1 * cs[3]) * dkf); }
                if (PASS_B) { const unsigned lo = *(const LAS unsigned*)(qrp + i * 256), hh = *(const LAS unsigned*)(qrp + i * 256 + 128);
                  const float a0 = __uint_as_float(lo << 16), a1 = __uint_as_float(lo & 0xffff0000u), b0 = __uint_as_float(hh << 16), b1 = __uint_as_float(hh & 0xffff0000u);
                  *(LAS unsigned*)(lds + QT + olo) = pk2((a0 * cs[0] - b0 * cs[1]) * dq, (a1 * cs[2] - b1 * cs[3]) * dq);
                  *(LAS unsigned*)(lds + QT + ohi) = pk2((b0 * cs[0] + a0 * cs[1]) * dq, (b1 * cs[2] + a1 * cs[3]) * dq); } }
            if (tid_c < 128) { const float e32 = exp2f(32.f * l2g); ((LAS float*)(lds + EREF))[tid_c] = e32; ((LAS float*)(lds + ELAST))[tid_c] = e32; }
        }
        if (chk + 1 < 4) LIN_DMA(chk + 1, (chk + 1) & 1, tid_c & 63);
        lds_barrier();
        u32x2 zpre[4];
        if (PASS_B) { const GAS bf16_t* zrow_ = Zg + (size_t)(chk * 64 + ct * 32 + q32) * DM + dt * 32 + 4 * hi;
#pragma unroll
            for (int g4 = 0; g4 < 4; ++g4) zpre[g4] = *(const GAS u32x2*)(zrow_ + 8 * g4); }
#pragma unroll
        for (int t = 0; t < 4; ++t)
#pragma unroll
            for (int g4 = 0; g4 < 4; ++g4) { const f32x4 er = *(const LAS f32x4*)(lds + EREF + (32 * t + 8 * g4 + 4 * hi) * 4);
#pragma unroll
                for (int e = 0; e < 4; ++e) S[t][4 * g4 + e] *= er[e]; }
        f32x16 oT;
#pragma unroll
        for (int r = 0; r < 16; ++r) oT[r] = 0.f;
        if (PASS_B && KN >= 3) {
            bf16x8 qp[8];
#pragma unroll
            for (int ks = 0; ks < 8; ++ks) qp[ks] = permfrag(lds + QT, ct * 32, ks, pb);
#pragma unroll
            for (int st = 0; st < 2; ++st) {
                if (st <= ct) {
                    f32x16 p;
#pragma unroll
                    for (int r = 0; r < 16; ++r) p[r] = 0.f;
                    bf16x8 kf[8];
#pragma unroll
                    for (int ks = 0; ks < 8; ++ks) kf[ks] = permfrag(lds + KT, st * 32, ks, pb);
#pragma unroll
                    for (int ks = 0; ks < 8; ++ks) p = mfma32(kf[ks], qp[ks], p);
                    if (st == ct) {
#pragma unroll
                        for (int r = 0; r < 16; ++r) { const int sl = (r & 3) + 8 * (r >> 2); if (sl > qm) p[r] = 0.f; }
                    }
#pragma unroll
                    for (int s2 = 0; s2 < 2; ++s2) oT = mfma32(trfrag1(lds + VT + bo, st * 32 + 16 * s2, dt, tb1), pack8(p, s2), oT);
                }
            }
#pragma unroll
            for (int t = 0; t < 4; ++t)
#pragma unroll
                for (int s2 = 0; s2 < 2; ++s2) oT = mfma32(pack8(S[t], s2), qp[2 * t + s2], oT);
        }
        if (KN >= 2)
#pragma unroll
        for (int ks = 0; ks < 4; ++ks) {
            const bf16x8 vb = trfrag2(lds + VT + bo, 16 * ks, dt, tb2);
#pragma unroll
            for (int t = 0; t < 4; ++t) S[t] = mfma32(trfrag2(lds + KT, 16 * ks, t, tb2), vb, S[t]);
        }
#pragma unroll
        for (int t = 0; t < 4; ++t)
#pragma unroll
            for (int g4 = 0; g4 < 4; ++g4) { const f32x4 el = *(const LAS f32x4*)(lds + ELAST + (32 * t + 8 * g4 + 4 * hi) * 4);
#pragma unroll
                for (int e = 0; e < 4; ++e) S[t][4 * g4 + e] *= el[e]; }
        if (PASS_B && KN < 4) { asm volatile("" :: "v"(oT)); asm volatile("s_waitcnt vmcnt(0)" ::: "memory"); lds_barrier(); }
        else if (PASS_B) {
            f32x4 gnv[4], bsv[4];
#pragma unroll
            for (int g4 = 0; g4 < 4; ++g4) { gnv[g4] = *(const GAS f32x4*)(gain + dt * 32 + 8 * g4 + 4 * hi);
                bsv[g4] = (f32x4){0.f, 0.f, 0.f, 0.f}; if (KIND == 1) bsv[g4] = *(const GAS f32x4*)(bias + dt * 32 + 8 * g4 + 4 * hi); }
            float s1 = 0.f, s2 = 0.f;
#pragma unroll
            for (int r = 0; r < 16; ++r) { s1 += oT[r]; s2 += oT[r] * oT[r]; }
            s2 = xhalf_sum(s2); if (KIND == 1) s1 = xhalf_sum(s1);
            if (hi == 0) { ((LAS float*)(lds + SSQ))[(ct * 4 + dt) * 32 + q32] = s2; if (KIND == 1) ((LAS float*)(lds + SSQ2))[(ct * 4 + dt) * 32 + q32] = s1; }
            asm volatile("s_waitcnt vmcnt(0)" ::: "memory");
            lds_barrier();
            const LAS float* sq = (const LAS float*)(lds + SSQ) + ct * 128 + q32;
            const float tot2 = (sq[0] + sq[32]) + (sq[64] + sq[96]);
            float mu = 0.f, rstd;
            if (KIND == 0) rstd = rsqrtf(tot2 * (1.f / 128.f) + EPS);
            else { const LAS float* sm = (const LAS float*)(lds + SSQ2) + ct * 128 + q32; mu = ((sm[0] + sm[32]) + (sm[64] + sm[96])) * (1.f / 128.f);
                   const float var = tot2 * (1.f / 128.f) - mu * mu; rstd = rsqrtf(fmaxf(var, 0.f) + EPS); }
            GAS bf16_t* yrow = Yg + (size_t)(chk * 64 + ct * 32 + q32) * DM + dt * 32 + 4 * hi;
#pragma unroll
            for (int g4 = 0; g4 < 4; ++g4) {
                const f32x4 gn = gnv[g4], bs = bsv[g4];
                const u32x2 z = zpre[g4];
                const float v0 = ((oT[4 * g4 + 0] - mu) * rstd * gn[0] + bs[0]) * __uint_as_float(z.x << 16), v1 = ((oT[4 * g4 + 1] - mu) * rstd * gn[1] + bs[1]) * __uint_as_float(z.x & 0xffff0000u);
                const float v2 = ((oT[4 * g4 + 2] - mu) * rstd * gn[2] + bs[2]) * __uint_as_float(z.y << 16), v3 = ((oT[4 * g4 + 3] - mu) * rstd * gn[3] + bs[3]) * __uint_as_float(z.y & 0xffff0000u);
                u32x2 w; w.x = pk2(v0, v1); w.y = pk2(v2, v3); *(GAS u32x2*)(yrow + 8 * g4) = w;
            }
        } else {
            asm volatile("s_waitcnt vmcnt(0)" ::: "memory"); lds_barrier();
        }
    }
    if (!PASS_B) {
        if (ct == 0) {
#pragma unroll
            for (int t = 0; t < 4; ++t)
#pragma unroll
                for (int g4 = 0; g4 < 4; ++g4) { f32x4 u4; u4[0] = S[t][4 * g4]; u4[1] = S[t][4 * g4 + 1]; u4[2] = S[t][4 * g4 + 2]; u4[3] = S[t][4 * g4 + 3];
                    u32x2 ub; ub.x = pk2(u4[0], u4[1]); ub.y = pk2(u4[2], u4[3]); *(GAS u32x2*)((GAS bf16_t*)Ubh + (size_t)sc * 16384 + ((dt * 4 + t) * 64 + lane) * 16 + 4 * g4) = ub; }
        }
        if (KIND == 0 && wave == 0) *(GAS f32x2*)(Dbh + sc * 128 + 2 * (tid & 63)) = (f32x2){dprod0, dprod1};
    }
#undef LIN_DMA
}

template <int KIND>
__device__ __forceinline__ void passA_item(LAS unsigned char* lds, const int tid, const GAS bf16_t* Xg, const GAS bf16_t* Vg, const GAS float* aux, const float gam,
                                           GAS float* Ubh, GAS float* Dbh, const int sc) {
    constexpr int XT_ = 0, VT_ = 65536, TOT_ = RING_BYTES + 2048;
    const int lane = tid & 63, wave = __builtin_amdgcn_readfirstlane(tid >> 6), hi = lane >> 5, dt = wave & 3, th = wave >> 2;
    { u32x4 xv[8], vv[8];
#pragma unroll
      for (int i = 0; i < 8; ++i) { const int cid = tid + 512 * i, row = cid >> 4, ch = cid & 15; const size_t go = (size_t)row * DM + ch * 8; xv[i] = *(const GAS u32x4*)(Xg + go); vv[i] = *(const GAS u32x4*)(Vg + go); }
#pragma unroll
      for (int i = 0; i < 8; ++i) { const int cid = tid + 512 * i, row = cid >> 4, ch = cid & 15; *(LAS u32x4*)(lds + XT_ + off16(row, ch)) = xv[i]; *(LAS u32x4*)(lds + VT_ + off16(row, ch)) = vv[i]; } }
    __syncthreads();
    if (KIND == 0) {
        const int dkp = tid & 63, tg = wave; const f32x2 lb2 = *(const GAS f32x2*)(aux + 2 * dkp);
        float r0 = 1.f, r1 = 1.f;
        unsigned xws[32];
#pragma unroll
        for (int i = 0; i < 32; ++i) { const int s_ = 32 * tg + i; xws[i] = *(const LAS unsigned*)(lds + XT_ + s_ * 256 + (((dkp >> 2) ^ swz(s_)) << 4) + (dkp & 3) * 4); }
#pragma unroll
        for (int i = 31; i >= 0; --i) { const int s_ = 32 * tg + i; LAS unsigned* p = (LAS unsigned*)(lds + XT_ + s_ * 256 + (((dkp >> 2) ^ swz(s_)) << 4) + (dkp & 3) * 4);
            const unsigned xw = xws[i];
            const float f0 = lb2.x + (1.f - lb2.x) * sigmoidf_(__uint_as_float(xw << 16)), f1 = lb2.y + (1.f - lb2.y) * sigmoidf_(__uint_as_float(xw & 0xffff0000u));
            *p = pk2((1.f - f0) * r0, (1.f - f1) * r1); r0 *= f0; r1 *= f1; }
        *(LAS f32x2*)(lds + TOT_ + (tg * 128 + 2 * dkp) * 4) = (f32x2){r0, r1};
    } else {
        const int dp = tid & 31, tg = tid >> 5; const float l2g = __log2f(gam);
        const GAS float* cst = aux + (size_t)(16 * tg) * 128 + dp * 4;
        unsigned los[16], his[16];
#pragma unroll
        for (int i = 0; i < 16; ++i) { const int s_ = 16 * tg + i; los[i] = *(const LAS unsigned*)(lds + XT_ + s_ * 256 + (((dp >> 2) ^ swz(s_)) << 4) + (dp & 3) * 4); his[i] = *(const LAS unsigned*)(lds + XT_ + s_ * 256 + ((((dp >> 2) + 8) ^ swz(s_)) << 4) + (dp & 3) * 4); }
#pragma unroll
        for (int i = 0; i < 16; ++i) { const int s_ = 16 * tg + i; const f32x4 cs = *(const GAS f32x4*)(cst + (size_t)i * 128);
            const float dkf = QK_SCALE * exp2f((float)(255 - s_) * l2g);
            LAS unsigned* plo = (LAS unsigned*)(lds + XT_ + s_ * 256 + (((dp >> 2) ^ swz(s_)) << 4) + (dp & 3) * 4); LAS unsigned* phi = (LAS unsigned*)(lds + XT_ + s_ * 256 + ((((dp >> 2) + 8) ^ swz(s_)) << 4) + (dp & 3) * 4);
            const unsigned lo = los[i], hh = his[i];
            const float a0 = __uint_as_float(lo << 16), a1 = __uint_as_float(lo & 0xffff0000u), b0 = __uint_as_float(hh << 16), b1 = __uint_as_float(hh & 0xffff0000u);
            *plo = pk2((a0 * cs[0] - b0 * cs[1]) * dkf, (a1 * cs[2] - b1 * cs[3]) * dkf); *phi = pk2((b0 * cs[0] + a0 * cs[1]) * dkf, (b1 * cs[2] + a1 * cs[3]) * dkf); }
    }
    __syncthreads();
    const int x_ = (lane >> 2) & 3, gl_ = 2 * ((lane >> 4) & 1) + ((lane & 3) >> 1);
    const int tb2 = (8 * hi + x_) * 256 + (x_ << 6) + ((gl_ ^ (2 * hi)) << 4) + 8 * (lane & 1);
    f32x16 acc[2];
#pragma unroll
    for (int t2 = 0; t2 < 2; ++t2)
#pragma unroll
        for (int r = 0; r < 16; ++r) acc[t2][r] = 0.f;
#pragma unroll
    for (int ks = 0; ks < 16; ++ks) {
        if (KIND == 0 && (ks & 1) == 0 && ks > 0) {
#pragma unroll
            for (int t2 = 0; t2 < 2; ++t2)
#pragma unroll
                for (int g4 = 0; g4 < 4; ++g4) { const f32x4 tg4 = *(const LAS f32x4*)(lds + TOT_ + ((ks >> 1) * 128 + 32 * (2 * th + t2) + 8 * g4 + 4 * hi) * 4);
#pragma unroll
                    for (int e = 0; e < 4; ++e) acc[t2][4 * g4 + e] *= tg4[e]; }
        }
        const bf16x8 vb = trfrag2(lds + VT_, 16 * ks, dt, tb2);
#pragma unroll
        for (int t2 = 0; t2 < 2; ++t2) acc[t2] = mfma32(trfrag2(lds + XT_, 16 * ks, 2 * th + t2, tb2), vb, acc[t2]);
    }
#pragma unroll
    for (int t2 = 0; t2 < 2; ++t2)
#pragma unroll
        for (int g4 = 0; g4 < 4; ++g4) { f32x4 u4; u4[0] = acc[t2][4 * g4]; u4[1] = acc[t2][4 * g4 + 1]; u4[2] = acc[t2][4 * g4 + 2]; u4[3] = acc[t2][4 * g4 + 3];
            u32x2 ub; ub.x = pk2(u4[0], u4[1]); ub.y = pk2(u4[2], u4[3]); *(GAS u32x2*)((GAS bf16_t*)Ubh + (size_t)sc * 16384 + ((dt * 4 + 2 * th + t2) * 64 + lane) * 16 + 4 * g4) = ub; }
    if (KIND == 0 && tid < 128) { const LAS float* tot = (const LAS float*)(lds + TOT_) + tid; float d = 1.f;
#pragma unroll
        for (int g = 0; g < 8; ++g) d *= tot[g * 128];
        Dbh[sc * 128 + tid] = d; }
}
}


namespace rgc {
using att::f32x16; using att::mfma32;
constexpr int TB = 128, NBLK = SEQ / TB;
constexpr int CXR = 0  , XF = 33792  , PRE = 66560  , XFF = 100352  ,
              GRP = 117248  , CAR = 121344  ;
__device__ __forceinline__ void rg_chain(LAS unsigned char* lds, const int tid, const int bid, const int G, const GAS bf16_t* H0, GAS bf16_t* Y, const GAS bf16_t* WRG,
                                         const GAS float* cwg, const GAS float* cbg, const GAS float* bag, const GAS float* bxg, const GAS float* spg) {
    const int lane = tid & 63, wave = __builtin_amdgcn_readfirstlane(tid >> 6), q32 = lane & 31, hi = lane >> 5, gate = wave & 1, tt = wave >> 1;
    for (int cid = bid; cid < 256; cid += G) {
        const int xs = cid & 7, sl = cid >> 3; const int grp = (G % 8 == 0) ? xs * 8 + (sl >> 2) : (cid >> 2), jt = (G % 8 == 0) ? (sl & 3) : (cid & 3), b = grp >> 3, hb = grp & 7;
        const GAS bf16_t* cx0 = H0 + (size_t)b * SEQ * DM + hb * 128; GAS bf16_t* y0 = Y + (size_t)b * SEQ * DM + hb * 128 + jt * 32;
        bf16x8 wf[8];
        { const GAS bf16_t* wp = WRG + (size_t)gate * 128 * 1024 + hb * 128 + (size_t)(jt * 32 + q32) * 1024 + 8 * hi;
#pragma unroll
          for (int ks = 0; ks < 8; ++ks) wf[ks] = *(const GAS bf16x8*)(wp + 16 * ks); }
        const int cp = tid & 63, t8 = __builtin_amdgcn_readfirstlane(tid >> 6), chc = hb * 128 + 2 * cp;
        const f32x2 w0 = *(const GAS f32x2*)(cwg + chc), w1 = *(const GAS f32x2*)(cwg + DM + chc), w2 = *(const GAS f32x2*)(cwg + 2 * DM + chc), w3 = *(const GAS f32x2*)(cwg + 3 * DM + chc), bb = *(const GAS f32x2*)(cbg + chc);
        const int j = tid & 31, tg = tid >> 5, chj = hb * 128 + jt * 32 + j;
        const float b_a = bag[chj], b_x = bxg[chj], s_p = spg[chj];
        if (tid < 64) ((LAS float*)(lds + CAR))[tid] = 0.f;
        u32x4 pv[4], phv;
#define RGC_ISSUE(blk) do { const GAS bf16_t* cxg = cx0 + (size_t)((blk) * TB) * DM; _Pragma("unroll") for (int i = 0; i < 4; ++i) { const int cidx = tid + 512 * i; pv[i] = *(const GAS u32x4*)(cxg + (size_t)(cidx >> 4) * DM + (cidx & 15) * 8); } \
            phv = (u32x4){0u, 0u, 0u, 0u}; if (tid < 48 && (blk) != 0) phv = *(const GAS u32x4*)(cxg - (size_t)(3 - (tid >> 4)) * DM + (tid & 15) * 8); } while (0)
#define RG_S1 do { _Pragma("unroll") for (int i = 0; i < 4; ++i) { const int cidx = tid + 512 * i; *(LAS u32x4*)(lds + CXR + ((cidx >> 4) + 3) * 256 + (cidx & 15) * 16) = pv[i]; } \
            if (tid < 48) *(LAS u32x4*)(lds + CXR + (tid >> 4) * 256 + (tid & 15) * 16) = phv; } while (0)
        RGC_ISSUE(0);
        RG_S1;
        if (1 < NBLK) RGC_ISSUE(1);
#pragma unroll 1
        for (int blk = 0; blk < NBLK; ++blk) {
            lds_barrier();
            { const LAS unsigned char* rp = lds + CXR + (16 * t8) * 256 + cp * 4;
              unsigned rr[19];
#pragma unroll
              for (int i = 0; i < 19; ++i) rr[i] = *(const LAS unsigned*)(rp + i * 256);
#define RGC_UNP2(r_) ((f32x2){__uint_as_float((r_) << 16), __uint_as_float((r_) & 0xffff0000u)})
              f32x2 x0 = RGC_UNP2(rr[0]), x1 = RGC_UNP2(rr[1]), x2 = RGC_UNP2(rr[2]);
              const int wb = t8 * 4096 + ((cp >> 2) << 4) + (cp & 3) * 4; const bool mine = (cp >> 4) == jt;
              LAS float* xfp = (LAS float*)(lds + XFF) + ((2 * cp) & 31) * 132 + 16 * t8;
#pragma unroll
              for (int i4 = 0; i4 < 4; ++i4) { f32x4 fa, fb;
#pragma unroll
                  for (int ii = 0; ii < 4; ++ii) { const int i = 4 * i4 + ii; const f32x2 x3 = RGC_UNP2(rr[i + 3]);
                      const f32x2 xf = bb + w0 * x0 + w1 * x1 + w2 * x2 + w3 * x3;
                      x0 = x1; x1 = x2; x2 = x3;
                      *(LAS unsigned*)(lds + XF + ((wb ^ (lin::swz(i) << 4)) + i * 256)) = pk2(xf.x, xf.y);
                      fa[ii] = xf.x; fb[ii] = xf.y; }
                  if (mine) { *(LAS f32x4*)(xfp + 4 * i4) = fa; *(LAS f32x4*)(xfp + 132 + 4 * i4) = fb; } } }
#undef RGC_UNP2
            lds_barrier();
            { f32x16 acc;
#pragma unroll
              for (int r = 0; r < 16; ++r) acc[r] = 0.f;
              const int xb = (tt * 32 + q32) * 256 + (lin::swz(q32) << 4);
#pragma unroll
              for (int ks = 0; ks < 8; ++ks) acc = mfma32(wf[ks], *(const LAS bf16x8*)(lds + XF + (xb ^ ((2 * ks + hi) << 4))), acc);
              LAS float* pp = (LAS float*)(lds + PRE) + gate * 32 * 132 + tt * 32 + q32;
#pragma unroll
              for (int r = 0; r < 16; ++r) pp[((r & 3) + 8 * (r >> 2) + 4 * hi) * 132] = acc[r]; }
            lds_barrier();
            float av[8], uv[8]; float Ag = 1.f, Hg = 0.f;
            const size_t yo = (size_t)(blk * TB + 8 * tg) * DM + j;
            const int jodd = j & 1;
            const size_t yo2 = (size_t)(blk * TB + 8 * tg + 4 * jodd) * DM + (j & ~1);
            unsigned zw[4];
#pragma unroll
            for (int i = 0; i < 4; ++i) zw[i] = *(const GAS unsigned*)(y0 + yo2 + (size_t)i * DM);
            { const LAS float* prp = (const LAS float*)(lds + PRE) + j * 132 + 8 * tg; const LAS float* pxp = (const LAS float*)(lds + XFF) + j * 132 + 8 * tg;
              const f32x4 pa0 = *(const LAS f32x4*)prp, pa1 = *(const LAS f32x4*)(prp + 4), pg0 = *(const LAS f32x4*)(prp + 32 * 132), pg1 = *(const LAS f32x4*)(prp + 32 * 132 + 4);
              const float pr[8] = {pa0[0], pa0[1], pa0[2], pa0[3], pa1[0], pa1[1], pa1[2], pa1[3]}, pg[8] = {pg0[0], pg0[1], pg0[2], pg0[3], pg1[0], pg1[1], pg1[2], pg1[3]};
              const f32x4 px0 = *(const LAS f32x4*)pxp, px1 = *(const LAS f32x4*)(pxp + 4); const float px[8] = {px0[0], px0[1], px0[2], px0[3], px1[0], px1[1], px1[2], px1[3]};
              const float NL2E = -1.4426950408889634f; const f32x2 nl2 = (f32x2){NL2E, NL2E}, one2 = (f32x2){1.f, 1.f};
              const f32x2 ca2 = (f32x2){b_a * NL2E, b_a * NL2E}, cx2 = (f32x2){b_x * NL2E, b_x * NL2E}, sp8 = (f32x2){-8.f * s_p, -8.f * s_p};
#pragma unroll
              for (int i = 0; i < 8; i += 2) {
                  const f32x2 ta = (f32x2){pr[i], pr[i + 1]} * nl2 + ca2, tx = (f32x2){pg[i], pg[i + 1]} * nl2 + cx2;
                  const f32x2 da = (f32x2){__builtin_amdgcn_exp2f(ta.x), __builtin_amdgcn_exp2f(ta.y)} + one2, dx = (f32x2){__builtin_amdgcn_exp2f(tx.x), __builtin_amdgcn_exp2f(tx.y)} + one2;
                  const f32x2 rgate = (f32x2){__builtin_amdgcn_rcpf(da.x), __builtin_amdgcn_rcpf(da.y)}, igate = (f32x2){__builtin_amdgcn_rcpf(dx.x), __builtin_amdgcn_rcpf(dx.y)};
                  const f32x2 la = rgate * sp8, e2 = la + la, lt = la * (f32x2){1.4426950408889634f, 1.4426950408889634f};
                  const f32x2 a = (f32x2){__builtin_amdgcn_exp2f(lt.x), __builtin_amdgcn_exp2f(lt.y)};
                  const f32x2 omB = one2 - a * a, omA = -(e2 + (f32x2){0.5f, 0.5f} * e2 * e2 + (f32x2){1.f / 6.f, 1.f / 6.f} * e2 * e2 * e2);
                  const f32x2 om = (f32x2){(e2.x > -0.01f) ? omA.x : omB.x, (e2.y > -0.01f) ? omA.y : omB.y};
                  const f32x2 u = (f32x2){__builtin_amdgcn_sqrtf(om.x), __builtin_amdgcn_sqrtf(om.y)} * igate * (f32x2){px[i], px[i + 1]};
                  av[i] = a.x; av[i + 1] = a.y; uv[i] = u.x; uv[i + 1] = u.y;
                  Ag *= a.x; Hg = a.x * Hg + u.x; Ag *= a.y; Hg = a.y * Hg + u.y; } }
            *(LAS f32x2*)(lds + GRP + (tg * 32 + j) * 8) = (f32x2){Ag, Hg};
            lds_barrier();
            float h = ((const LAS float*)(lds + CAR))[(blk & 1) * 32 + j];
            {
                f32x2 ah[15];
#pragma unroll
                for (int g = 0; g < 15; ++g) ah[g] = *(const LAS f32x2*)(lds + GRP + (g * 32 + j) * 8);
#pragma unroll
                for (int g = 0; g < 15; ++g) h = (g < tg) ? ah[g].x * h + ah[g].y : h;
            }
            float yl[4], yh[4];
#pragma unroll
            for (int i = 0; i < 4; ++i) { const unsigned pw = (unsigned)__builtin_amdgcn_update_dpp(0, (int)zw[i], 0xB1, 0xF, 0xF, false);
                const unsigned own = jodd ? (zw[i] & 0xffff0000u) : (zw[i] << 16), oth = jodd ? (pw & 0xffff0000u) : (pw << 16);
                yl[i] = __uint_as_float(jodd ? oth : own); yh[i] = __uint_as_float(jodd ? own : oth); }
#pragma unroll
            for (int i = 0; i < 4; ++i) { h = av[i] * h + uv[i]; yl[i] *= h; }
#pragma unroll
            for (int i = 0; i < 4; ++i) { h = av[4 + i] * h + uv[4 + i]; yh[i] *= h; }
            unsigned yw[4];
#pragma unroll
            for (int i = 0; i < 4; ++i) { const float keep = jodd ? yh[i] : yl[i], send = jodd ? yl[i] : yh[i];
                const float recv = __int_as_float(__builtin_amdgcn_update_dpp(0, __float_as_int(send), 0xB1, 0xF, 0xF, false));
                yw[i] = jodd ? pk2(recv, keep) : pk2(keep, recv); }
            if (tg == 15) ((LAS float*)(lds + CAR))[((blk + 1) & 1) * 32 + j] = h;
            if (blk + 1 < NBLK) { RG_S1; if (blk + 2 < NBLK) RGC_ISSUE(blk + 2); }
#pragma unroll
            for (int i = 0; i < 4; ++i) *(GAS unsigned*)(y0 + yo2 + (size_t)i * DM) = yw[i];
        }
#undef RG_S1
        __syncthreads();
#undef RGC_ISSUE
    }
}
}

struct Ctx { LAS unsigned char* lds; LAS u64* ptab; LAS pg8::GD* gd; int tid, lane, wave, bid, G, gw, NGW; };
__device__ __forceinline__ Ctx make_ctx(LAS unsigned char* lds_k, int wave_s) {
    Ctx c; int tid;
    asm volatile("v_mbcnt_lo_u32_b32 %0, -1, 0\n\tv_mbcnt_hi_u32_b32 %0, -1, %0\n\tv_lshl_add_u32 %0, %1, 6, %0" : "=&v"(tid) : "s"(wave_s));
    int bid = blockIdx.x, G = gridDim.x; unsigned lo_ = 0u; asm volatile("" : "+s"(bid), "+s"(G), "+s"(lo_));
    c.lds = lds_k + lo_; c.ptab = (LAS u64*)(c.lds + PTR_OFF); c.gd = (LAS pg8::GD*)(c.lds + GD_OFF);
    c.tid = tid; c.lane = tid & 63; c.wave = __builtin_amdgcn_readfirstlane(tid >> 6); c.bid = bid; c.G = G; c.gw = bid * NWAVES + c.wave; c.NGW = G * NWAVES;
    return c;
}
#define CTX_UNPACK LAS unsigned char* lds = c.lds; LAS u64* ptab = c.ptab; LAS pg8::GD* gd = c.gd; const int tid = c.tid, lane = c.lane, wave = c.wave, bid = c.bid, G = c.G, gw = c.gw, NGW = c.NGW; \
    (void)lds; (void)ptab; (void)gd; (void)tid; (void)lane; (void)wave; (void)bid; (void)G; (void)gw; (void)NGW
__device__ __forceinline__ void ph_pro(const Ctx c) {
    CTX_UNPACK;
    WSDEF;
    LAS float* scr = (LAS float*)(lds + wave * 16384);
    GAS bf16_t* WEIN = (GAS bf16_t*)(ws + WS_WEIN); GAS bf16_t* WOIN = (GAS bf16_t*)(ws + WS_WOIN);
    GAS bf16_t* WEOUT = (GAS bf16_t*)(ws + WS_WEOUT); GAS bf16_t* WOOUT = (GAS bf16_t*)(ws + WS_WOOUT);
    GAS bf16_t* WXQ = (GAS bf16_t*)(ws + WS_WXQ); GAS bf16_t* WXKV = (GAS bf16_t*)(ws + WS_WXKV); GAS bf16_t* WXO = (GAS bf16_t*)(ws + WS_WXO);
    GAS bf16_t* MN = (GAS bf16_t*)(ws + WS_MN); GAS bf16_t* XB = (GAS bf16_t*)(ws + WS_XB); GAS float* LB = (GAS float*)(ws + WS_MISC);
    const GAS float* x = INP(I_X);
    const GAS float* evw = INP(I_EVWIN); const GAS float* odw = INP(I_ODWIN);
    const GAS float* evo = INP(I_EVWOUT); const GAS float* odo = INP(I_ODWOUT);
    const GAS float* odn = INP(I_ODN); const GAS float* xan = INP(I_XAN);
    const GAS float* wq = INP(I_XAWQ); const GAS float* wkv = INP(I_XAWKV); const GAS float* wo = INP(I_XAWO);
    constexpr int NITEMS = (3 * 1536 + 9 * 512 + 4 * 256 + 2 * 512 + 2 * 64) / 2;
    auto tr_find = [&](int it_, TrD& d_) {
        int r = it_;
        if (tr_seg(r, evw, 8192, 1024, 0, 3072, WEIN, 0, nullptr, d_)) return;
        if (tr_seg(r, evw, 8192, 1024, 6144, 1024, WEIN, 3072, nullptr, d_)) return;
        if (tr_seg(r, evw, 8192, 1024, 3072, 3072, WEIN, 4096, nullptr, d_)) return;
        if (tr_seg(r, evw, 8192, 1024, 7168, 1024, WEIN, 7168, nullptr, d_)) return;
        if (tr_seg(r, odw, 6144, 1024, 0, 1024, WOIN, 0, odn, d_)) return;
        if (tr_seg(r, odw, 6144, 1024, 4096, 1024, WOIN, 1024, odn, d_)) return;
        if (tr_seg(r, odw, 6144, 1024, 1024, 3072, WOIN, 2048, odn, d_)) return;
        if (tr_seg(r, odw, 6144, 1024, 5120, 1024, WOIN, 5120, odn, d_)) return;
        if (tr_seg(r, evo, 1024, 1024, 0, 1024, WEOUT, 0, nullptr, d_)) return;
        if (tr_seg(r, evo + (size_t)1024 * 1024, 1024, 1024, 0, 1024, WEOUT + (size_t)1024 * 1024, 0, nullptr, d_)) return;
        if (tr_seg(r, odo, 1024, 1024, 0, 1024, WOOUT, 0, nullptr, d_)) return;
        if (tr_seg(r, odo + (size_t)1024 * 1024, 1024, 1024, 0, 1024, WOOUT + (size_t)1024 * 1024, 0, nullptr, d_)) return;
        if (tr_seg(r, wq, 512, 1024, 0, 512, WXQ, 0, xan, d_)) return;
        if (tr_seg(r, wq + (size_t)1024 * 512, 512, 1024, 0, 512, WXQ + (size_t)512 * 1024, 0, xan + 1024, d_)) return;
        if (tr_seg(r, wkv, 1024, 1024, 0, 1024, WXKV, 0, nullptr, d_)) return;
        if (tr_seg(r, wkv + (size_t)1024 * 1024, 1024, 1024, 0, 1024, WXKV + (size_t)1024 * 1024, 0, nullptr, d_)) return;
        if (tr_seg(r, wo, 1024, 512, 0, 1024, WXO, 0, nullptr, d_)) return;
        if (tr_seg(r, wo + (size_t)512 * 1024, 1024, 512, 0, 1024, WXO + (size_t)1024 * 512, 0, nullptr, d_)) return;
        if (tr_seg(r, INP(I_WA), 128, 1024, 0, 128, (GAS bf16_t*)(ws + WS_WRG), 0, nullptr, d_)) return;
        tr_seg(r, INP(I_WX), 128, 1024, 0, 128, (GAS bf16_t*)(ws + WS_WRG) + (size_t)128 * 1024, 0, nullptr, d_);
    };
    {
        int it = gw; bool have = it < NITEMS;
        TrD cur{}, nx{}; f32x4 va[16], vb[16]; float ga[16], gb[16];
        if (have) { tr_find(it, cur); tr_load(cur, va, ga, lane); }
        while (have) {
            const int itn = it + NGW; const bool hn = itn < NITEMS;
            if (hn) { tr_find(itn, nx); tr_load(nx, vb, gb, lane); }
            tr_store(cur, va, ga, scr, lane);
            if (hn) { cur = nx;
#pragma unroll
                for (int i = 0; i < 16; ++i) { va[i] = vb[i]; ga[i] = gb[i]; } }
            have = hn; it = itn;
        }
    }
    const GAS float* evn = INP(I_EVN);
    for (int m = gw; m < MROWS; m += 2 * NGW) { rms_row2_bf16(x + (size_t)m * DM, x + (size_t)(m + NGW) * DM, evn, XB + (size_t)m * DM, XB + (size_t)(m + NGW) * DM, lane); }
    const GAS float* mem = INP(I_MEM); const GAS float* xamn = INP(I_XAMN);
    for (int m = gw; m < 2 * NB * MEML; m += NGW) { const int l = m / (NB * MEML), r = m % (NB * MEML);
        rms_row_bf16(mem + (size_t)r * DM, xamn + l * DM, MN + (size_t)m * DM, lane); }
    {
        GAS float* RT = (GAS float*)(ws + WS_XAKV); const GAS int* pos = (const GAS int*)INP(I_POS);
        for (int i = bid * NTHR + tid; i < MROWS * 16; i += G * NTHR) { const int row = i >> 4, j = i & 15; const float ang = (float)pos[row] * powf(500000.f, -(float)j / 16.f);
            *(GAS f32x2*)(RT + (size_t)i * 2) = (f32x2){cosf(ang), sinf(ang)}; }
    }
    {
        const int c = bid * NTHR + tid;
        if (c < 1024) { const GAS float* lbl = INP(I_LBL); const float l0 = lbl[c], l1 = lbl[1024 + c], l2 = lbl[2048 + c];
            const float m = fmaxf(l0, fmaxf(l1, l2)); const float e0 = expf(l0 - m), e1 = expf(l1 - m), e2 = expf(l2 - m); LB[c] = e0 / (e0 + e1 + e2);
            const float nl = -INP(I_LAM)[c]; LB[1024 + c] = (nl > 20.f) ? nl : log1pf(expf(nl)); }
    }
}
template <int ph> __device__ __forceinline__ void ph_gemm(const Ctx c) {
    CTX_UNPACK;
    int K = 1024; if (ph == PH_XO0 || ph == PH_XO1) K = 512;
    if (tid == 0) {
        WSDEF; OUTDEF; HDEF;
        GAS bf16_t* WEIN = (GAS bf16_t*)(ws + WS_WEIN); GAS bf16_t* WOIN = (GAS bf16_t*)(ws + WS_WOIN);
        GAS bf16_t* WEOUT = (GAS bf16_t*)(ws + WS_WEOUT); GAS bf16_t* WOOUT = (GAS bf16_t*)(ws + WS_WOOUT);
        GAS bf16_t* WXQ = (GAS bf16_t*)(ws + WS_WXQ); GAS bf16_t* WXKV = (GAS bf16_t*)(ws + WS_WXKV); GAS bf16_t* WXO = (GAS bf16_t*)(ws + WS_WXO);
        GAS bf16_t* XAKV = (GAS bf16_t*)(ws + WS_XAKV); GAS bf16_t* MN = (GAS bf16_t*)(ws + WS_MN); GAS bf16_t* XB = (GAS bf16_t*)(ws + WS_XB);
        GAS float* SSQ = (GAS float*)(ws + WS_CTL + CTL_SSQ);
#define d0 gd[0]
#define d1 gd[1]
        d1.nM = 1; d1.nN = 1; d1.nunits = 0; d1.diag = 0; d0.rope = nullptr; d0.kms = nullptr; d1.rope = nullptr; d1.kms = nullptr; d0.zshift = 0; d1.zshift = 0;
        GAS bf16_t* STB = (GAS bf16_t*)(ws + WS_ST);
        if (ph == PH_GEMM_A0 || ph == PH_GEMM_B0) {
            d0.A = XB; d0.Bt = WEIN + (ph == PH_GEMM_B0 ? (size_t)4096 * 1024 : 0); d0.nM = 64; d0.nN = 16; d0.kind = 0;
            d0.O = H0; d0.ldc = 1024; d0.split_cols = 1024; d0.split_stride = (long)HSTRIDE; d0.silu_t = 3; d0.ssq_r = nullptr; d0.scale = 1.f;
            if (ph == PH_GEMM_B0) { d0.rope = (const GAS float*)(ws + WS_XAKV); d0.kms = (GAS float*)(ws + WS_CTL + CTL_KMS); d0.zshift = 1;
}
        } else if (ph == PH_GEMM_C1) {
            d0.A = XB; d0.Bt = WOIN; d0.nM = 64; d0.nN = 8; d0.kind = 0;
            d0.O = H0; d0.ldc = 1024; d0.split_cols = 1024; d0.split_stride = (long)(4 * HSTRIDE); d0.silu_t = 1; d0.ssq_r = SSQ + 1 * MROWS; d0.scale = 1.f;

        } else if (ph == PH_GEMM_D1) {
            d0.A = XB; d0.Bt = WOIN + (size_t)2048 * 1024; d0.nM = 64; d0.nN = 16; d0.kind = 0;
            d0.O = H0; d0.ldc = 1024; d0.split_cols = 1024; d0.split_stride = (long)HSTRIDE; d0.silu_t = 3; d0.ssq_r = SSQ + 1 * MROWS; d0.scale = 1.f;
            d1.A = XB; d1.Bt = WOIN; d1.nM = 64; d1.nN = 8; d1.kind = 0; d1.diag = 0; d1.nunits = 512;
            d1.O = (GAS bf16_t*)out; d1.ldc = 1024; d1.split_cols = 1024; d1.split_stride = (long)HSTRIDE; d1.silu_t = 1; d1.ssq_r = SSQ + 1 * MROWS; d1.scale = 1.f;
        } else if (ph == PH_OUT_B0 || ph == PH_OUT_C1) {
            d0.nM = 64; d0.nN = 4; d0.kind = -1; d0.zshift = -1;
            d1.nM = 64; d1.nN = 4; d1.kind = 2; d1.out = out; d1.xb = XB; d1.ssq_w = SSQ + ((ph == PH_OUT_B0) ? 0 : 2) * MROWS;
            if (ph == PH_OUT_B0) { d0.A = Y; d0.Bt = WEOUT; d1.A = STB; d1.Bt = WEOUT + (size_t)1024 * 1024; d1.base = INP(I_X); }
            else { d0.A = (GAS bf16_t*)out + HSTRIDE; d0.Bt = WOOUT; d1.A = Y; d1.Bt = WOOUT + (size_t)1024 * 1024; d1.base = (const GAS float*)XB; }
        } else if (ph == PH_XQ0 || ph == PH_XQ1) {
            const int l = (ph == PH_XQ1);
            d0.A = XB; d0.Bt = WXQ + (size_t)l * 512 * 1024; d0.nM = 64; d0.nN = l ? 4 : 2; d0.kind = 0;
            d0.O = H0; d0.ldc = 512; d0.split_cols = 0; d0.silu_t = -1; d0.ssq_r = SSQ + (l ? 2 : 0) * MROWS; d0.scale = QK_SCALE * LOG2E;
            if (l == 0) {
                d1.A = MN; d1.Bt = WXKV; d1.nM = 16; d1.nN = 8; d1.kind = 0; d1.diag = 1;
                d1.O = XAKV; d1.ldc = 1024; d1.split_cols = 1024; d1.split_stride = 0; d1.silu_t = -1; d1.ssq_r = nullptr; d1.scale = 1.f;
                d1.nunits = 64;
            }
        } else {
            const int l = (ph == PH_XO1);
            d0.A = H1; d0.Bt = WXO + (size_t)l * 1024 * 512; d0.nM = 64; d0.nN = 4; d0.kind = l ? ((G == 256) ? 4 : 1) : 2;
            d0.base = (const GAS float*)XB; d0.out = out; d0.xb = XB; d0.ssq_w = SSQ + (l ? 3 : 1) * MROWS;
            if (l) { d0.ssq_r = INP(I_FIN); d0.kms = (GAS float*)(ws + WS_CTL + 8192); }
        }
        d0.nunits = d0.nM * d0.nN;
#undef d0
#undef d1
    }
    __syncthreads();
    if (ph == PH_GEMM_A0 || ph == PH_GEMM_B0 || ph == PH_GEMM_D1 || ph == PH_GEMM_C1) {
        const int grp_ = (bid >> 3) & 3;
        for (int i_ = 0; i_ < grp_; ++i_) { __builtin_amdgcn_s_sleep(36); }
    }
    pg8::Sched S; S.G = G; S.c = bid;
    pg8::gemm_phase<true, true, ph == PH_XO1, (ph == PH_XO0 || ph == PH_OUT_C1 || ph == PH_XO1), (ph == PH_XO1), (ph == PH_XQ1)>(lds, K, S, gd, tid);
}
template <bool PASS_B, bool DRY = false, int KN = 4> __device__ __forceinline__ void ph_hgrn(const Ctx c) {
    CTX_UNPACK;
    WSDEF; HDEF; const GAS float* LB = (const GAS float*)(ws + WS_MISC); GAS float* UST = (GAS float*)(ws + WS_ST); GAS float* DST = (GAS float*)(ws + WS_MISC + 64 * 1024);
    const GAS float* gain = INP(I_EVGAIN);
    for (int item = bid; item < (PASS_B ? 512 : 448); item += G) {
        const int bh = PASS_B ? (item >> 3) : (item / 7), sc = PASS_B ? ((item >= 256) ? 7 - (item & 7) : (item & 7)) : (item % 7), b = bh >> 3, hh = bh & 7;
        const size_t ro = ((size_t)b * SEQ + sc * 256) * DM + hh * HD;
        if (!PASS_B) lin::passA_item<0>(lds, tid, H1 + ro, H2 + ro, LB + hh * HD, 0.f, (GAS float*)((GAS bf16_t*)UST + (size_t)bh * 8 * 16384), DST + bh * 8 * 128, sc);
        else lin::linatt_item<0, PASS_B, KN>(lds, tid, H0 + ro, H1 + ro, H2 + ro, LB + hh * HD, 0.f, 0.f, (GAS float*)((GAS bf16_t*)UST + (size_t)bh * 8 * 16384), DST + bh * 8 * 128, sc, (DRY ? (GAS bf16_t*)lds_ptr(ptab + 26) : Y) + ro, Y + ro, gain + hh * HD, nullptr);
        __syncthreads();
    }
}
template <bool DRY, int KN = 4> __device__ __forceinline__ void ph_moba(const Ctx c) {
    CTX_UNPACK;
    WSDEF; HDEF; const GAS float* KMEAN = (const GAS float*)(ws + WS_CTL + CTL_KMS); GAS bf16_t* OUTB = (GAS bf16_t*)(ws + WS_ST); (void)DRY;
    for (int u = bid; u < 256; u += G) {
        const int xs = u & 7, sl = u >> 3; const int bh = (G % 8 == 0) ? xs * 8 + (sl >> 2) : (u >> 2), pr = (G % 8 == 0) ? (sl & 3) : (u & 3), b = bh >> 3, hh = bh & 7;
#pragma unroll 1
        for (int half = 0; half < 2; ++half) {
            const int qb = half ? pr : 7 - pr;
            const size_t row0 = (size_t)b * SEQ + qb * 256, bo = (size_t)b * SEQ * DM + hh * HD;
            att::attn_unit<1, KN>(lds, tid, H0 + row0 * DM + hh * HD, DM, QK_SCALE * LOG2E, H1 + bo, H2 + bo, DM, qb, KMEAN + (size_t)b * 8 * DM + hh * HD,
                              OUTB + row0 * DM + hh * HD, DM, OUTB + row0 * DM + hh * HD);
        }
    }
}
template <int ph> __device__ __forceinline__ void ph_xatt(const Ctx c) {
    CTX_UNPACK;
    const int l = (ph == PH_XATT1);
    WSDEF; HDEF;
    if (ph == PH_XATT0) {
        GAS float* TAB = (GAS float*)(ws + WS_MN); const GAS int* pos = (const GAS int*)INP(I_POS);
        const float fr_ = powf(10000.f, -(float)(tid & 63) / 64.f);
        for (int i = bid * NTHR + tid; i < MROWS * 64; i += G * NTHR) {
            float sn_, cs_; sincosf((float)pos[i >> 6] * fr_, &sn_, &cs_);
            *(GAS f32x2*)(TAB + (size_t)i * 2) = (f32x2){cs_, sn_};
        }
    } const GAS bf16_t* KV = (const GAS bf16_t*)(ws + WS_XAKV) + (size_t)l * 2048 * 1024;
    for (int u = bid; u < 256; u += G) {
        const int b = u >> 5, hh = (u >> 3) & 3, qt = u & 7;
        const size_t row0 = (size_t)b * SEQ + qt * 256;
        att::attn_unit<0>(lds, tid, H0 + row0 * 512 + hh * HD, 512, 1.f, KV + (size_t)b * 256 * 1024 + hh * HD, KV + (size_t)b * 256 * 1024 + 512 + hh * HD, 1024, 0, nullptr,
                          H1 + row0 * 512 + hh * HD, 512, nullptr);
    }
}
__device__ __forceinline__ void ph_rglru(const Ctx c) {
    CTX_UNPACK;
    WSDEF; HDEF;
    OUTDEF;
    rgc::rg_chain(lds, tid, bid, G, (const GAS bf16_t*)out, (GAS bf16_t*)out + HSTRIDE, (const GAS bf16_t*)(ws + WS_WRG), INP(I_CW), INP(I_CB), INP(I_BA), INP(I_BX), (const GAS float*)(ws + WS_MISC + 4096));
}
template <bool PASS_B, bool DRY = false> __device__ __forceinline__ void ph_ret(const Ctx c) {
    CTX_UNPACK;
    WSDEF; HDEF; GAS float* UST = (GAS float*)(ws + WS_ST); const GAS float* TAB = (const GAS float*)(ws + WS_MN);
    const GAS float* gain = INP(I_RGAIN); const GAS float* bias = INP(I_RBIAS);
    for (int item = bid; item < (PASS_B ? 512 : 448); item += G) {
        const int bh = PASS_B ? (item >> 3) : (item / 7), sc = PASS_B ? ((item >= 256) ? 7 - (item & 7) : (item & 7)) : (item % 7), b = bh >> 3, hh = bh & 7;
        const size_t row0 = (size_t)b * SEQ + sc * 256, ro = row0 * DM + hh * HD;
        const float gam = 1.f - exp2f(-5.f - (float)hh);
        if (!PASS_B) lin::passA_item<1>(lds, tid, H1 + ro, H2 + ro, TAB + row0 * 128, gam, (GAS float*)((GAS bf16_t*)UST + (size_t)bh * 8 * 16384), nullptr, sc);
        else lin::linatt_item<1, PASS_B>(lds, tid, H0 + ro, H1 + ro, H2 + ro, TAB + row0 * 128, gam, exp2f(256.f * __log2f(gam)), (GAS float*)((GAS bf16_t*)UST + (size_t)bh * 8 * 16384), nullptr, sc, (DRY ? (GAS bf16_t*)(ws + WS_XB) : Y) + ro, Y + ro, gain + hh * HD, bias + hh * HD);
        __syncthreads();
    }
}
__device__ __forceinline__ void ph_fin(const Ctx c) {
    CTX_UNPACK;
    OUTDEF; const GAS float* fin = INP(I_FIN);
    for (int m = gw; m < MROWS; m += NGW) {
        GAS f32x4* xr = (GAS f32x4*)(out + (size_t)m * DM) + lane; const GAS f32x4* gr = (const GAS f32x4*)fin + lane;
        f32x4 v[4]; float s = 0.f;
#pragma unroll
        for (int j = 0; j < 4; ++j) { v[j] = xr[64 * j]; s += (v[j].x * v[j].x + v[j].y * v[j].y) + (v[j].z * v[j].z + v[j].w * v[j].w); }
        const float r = rsqrtf(wave_sum(s) * (1.f / DM) + EPS);
#pragma unroll
        for (int j = 0; j < 4; ++j) { const f32x4 g = gr[64 * j]; xr[64 * j] = (f32x4){v[j].x * r * g.x, v[j].y * r * g.y, v[j].z * r * g.z, v[j].w * r * g.w}; }
    }
}

#define IN(k) (ph_lo <= (k) && (k) < ph_hi)
#define SEAM(k) do { if (IN(k) && IN((k) + 1)) xcd_barrier(bar); } while (0)
__global__ void __launch_bounds__(NTHR, 2) mega_fwd(Args args) {
    extern __shared__ __attribute__((aligned(16))) unsigned char lds_raw[];
    LAS unsigned char* lds_k = (LAS unsigned char*)lds_raw;
    const int tid_k = threadIdx.x;
    for (int u = tid_k; u < (LDS_BYTES - RING_BYTES) / 4; u += NTHR) ((LAS unsigned*)(lds_k + RING_BYTES))[u] = 0u;
    __syncthreads();
    if (tid_k == 0) {
        LAS u64* ptab = (LAS u64*)(lds_k + PTR_OFF);
#pragma unroll
        for (int i = 0; i < 26; ++i) ptab[i] = (u64)args.in[i];
        ptab[26] = (u64)args.out; ptab[27] = (u64)args.ws;
    }
    __syncthreads();
    XcdBarrier bar;
    { LAS u64* ptab = (LAS u64*)(lds_k + PTR_OFF); WSDEF; bar = xcd_barrier_post((GAS unsigned*)(ws + WS_CTL) + CW_BAR, (volatile LAS unsigned*)(lds_k + MISC_OFF) + 8); bar.wave = __builtin_amdgcn_readfirstlane(tid_k >> 6); }
    const int ph_lo = args.ph_lo, ph_hi = args.ph_hi;
    const int wave_s = __builtin_amdgcn_readfirstlane(tid_k >> 6);

    if (IN(PH_PRO)) ph_pro(make_ctx(lds_k, wave_s));
    SEAM(PH_PRO);
    if (IN(PH_GEMM_A0)) ph_gemm<PH_GEMM_A0>(make_ctx(lds_k, wave_s));
    SEAM(PH_GEMM_A0);
    if (IN(PH_HGRN_A)) ph_hgrn<false>(make_ctx(lds_k, wave_s));
    SEAM(PH_HGRN_A);
    if (IN(PH_HGRN)) ph_hgrn<true>(make_ctx(lds_k, wave_s));
    SEAM(PH_HGRN);
    if (IN(PH_GEMM_B0)) ph_gemm<PH_GEMM_B0>(make_ctx(lds_k, wave_s));
    SEAM(PH_GEMM_B0);
    if (IN(PH_MOBA)) ph_moba<false>(make_ctx(lds_k, wave_s));
    SEAM(PH_MOBA);
    if (IN(PH_OUT_B0)) ph_gemm<PH_OUT_B0>(make_ctx(lds_k, wave_s));
    SEAM(PH_OUT_B0);
    if (IN(PH_XQ0)) ph_gemm<PH_XQ0>(make_ctx(lds_k, wave_s));
    SEAM(PH_XQ0);
    if (IN(PH_XATT0)) ph_xatt<PH_XATT0>(make_ctx(lds_k, wave_s));
    SEAM(PH_XATT0);
    if (IN(PH_XO0)) ph_gemm<PH_XO0>(make_ctx(lds_k, wave_s));
    SEAM(PH_XO0);
    if (IN(PH_GEMM_D1)) ph_gemm<PH_GEMM_D1>(make_ctx(lds_k, wave_s));
    SEAM(PH_GEMM_D1);
    if (IN(PH_RET_A)) ph_ret<false>(make_ctx(lds_k, wave_s));
    SEAM(PH_RET_A);
    if (IN(PH_RET)) ph_ret<true>(make_ctx(lds_k, wave_s));
    if (IN(PH_RET) && IN(PH_RGLRU)) __syncthreads();
    if (IN(PH_RGLRU)) ph_rglru(make_ctx(lds_k, wave_s));
    SEAM(PH_RGLRU);
    if (IN(PH_OUT_C1)) ph_gemm<PH_OUT_C1>(make_ctx(lds_k, wave_s));
    SEAM(PH_OUT_C1);
    if (IN(PH_XQ1)) ph_gemm<PH_XQ1>(make_ctx(lds_k, wave_s));
    SEAM(PH_XQ1);
    if (IN(PH_XATT1)) ph_xatt<PH_XATT1>(make_ctx(lds_k, wave_s));
    SEAM(PH_XATT1);
    if (IN(PH_XO1)) ph_gemm<PH_XO1>(make_ctx(lds_k, wave_s));
    if (gridDim.x != 256) {
        SEAM(PH_XO1);
        if (IN(PH_FIN)) ph_fin(make_ctx(lds_k, wave_s));
    }
}

extern "C" void kernel_launch(void* const* d_in, const int* in_sizes, int n_in, void* d_out, int out_size, void* d_ws, size_t ws_size, hipStream_t stream) {
    static int grid = 0;
    if (grid == 0) {
        if (n_in != 26 || out_size != MROWS * DM || ws_size < WS_END) { fprintf(stderr, "kernel_launch: unexpected shapes (n_in %d out %d ws %zu)\n", n_in, out_size, ws_size); grid = -1; return; }
        int dev = 0, cus = 0, per_cu = 0;
        hipGetDevice(&dev); hipDeviceGetAttribute(&cus, hipDeviceAttributeMultiprocessorCount, dev);
        hipFuncSetAttribute((const void*)mega_fwd, hipFuncAttributeMaxDynamicSharedMemorySize, LDS_BYTES);
        hipOccupancyMaxActiveBlocksPerMultiprocessor(&per_cu, (const void*)mega_fwd, NTHR, LDS_BYTES);
        if (per_cu < 1) { fprintf(stderr, "kernel_launch: occupancy query says %d blocks/CU\n", per_cu); per_cu = 1; }
        (void)hipGetLastError();
        grid = cus;
    }
    if (grid < 0) return;
    hipMemsetAsync((char*)d_ws + WS_CTL, 0, CTL_ZERO_BYTES, stream);
    Args a{};
    for (int i = 0; i < 26; ++i) a.in[i] = d_in[i];
    a.out = (float*)d_out; a.ws = (unsigned char*)d_ws;
#ifndef MK_PER_PHASE
    a.ph_lo = 0; a.ph_hi = PH_COUNT;
    void* kargs[] = {&a};
    hipError_t e = hipLaunchCooperativeKernel((const void*)mega_fwd, dim3(grid), dim3(NTHR), kargs, LDS_BYTES, stream);
    if (e != hipSuccess) fprintf(stderr, "cooperative launch failed: %s (grid %d)\n", hipGetErrorString(e), grid);
#else
    for (int p = 0; p < PH_COUNT; ++p) { a.ph_lo = p; a.ph_hi = p + 1; hipLaunchKernelGGL(mega_fwd, dim3(grid), dim3(NTHR), LDS_BYTES, stream, a); }
#endif
}
```
